# Optimizing an MI355X kernel written in HIP

```python
import math
import jax, jax.numpy as jnp
from jax import lax
import numpy as np

D_MODEL = 1024
BATCH = 2
SEQ = 8192
DEPTH = 2

N_A_LAYERS = DEPTH // 2
N_B_LAYERS = DEPTH - N_A_LAYERS

MLSTM_HEADS = 4
MLSTM_INNER = 2 * D_MODEL
MLSTM_HEAD_DIM = MLSTM_INNER // MLSTM_HEADS
CONV_WIDTH = 4
MLSTM_CHUNK = 128

ATTN_HEADS = 16
ATTN_HEAD_DIM = D_MODEL // ATTN_HEADS
MOBA_BLOCK = 256
MOBA_TOPK = 3
MOBA_QCHUNK = 32

N_EXPERTS = 16
N_GROUPS = 4
EXPERTS_PER_GROUP = N_EXPERTS // N_GROUPS
MOE_TOPK = 2
D_FF_EXPERT = 512
MOE_ROW_BLOCK = 256

DEEPNORM_ALPHA = (2.0 * DEPTH) ** 0.25
DEEPNORM_BETA = (8.0 * DEPTH) ** -0.25
LN_EPS = 1e-5
N_MOD_PER_LAYER = 6

kernel_name = 'hybrid_mlstm_moba_groupmoe'


def layer_norm(x, g, b):
    xf = x.astype(jnp.float32)
    mu = xf.mean(-1, keepdims=True)
    var = jnp.square(xf - mu).mean(-1, keepdims=True)
    return ((xf - mu) * lax.rsqrt(var + LN_EPS) * g + b).astype(x.dtype)


def modulate(x, shift, scale):
    return x * (1 + scale[:, None, :]) + shift[:, None, :]


def causal_conv(x, w, b):
    K, C = w.shape
    y = lax.conv_general_dilated(x, w[:, None, :], window_strides=(1,), padding=[(K - 1, 0)],
                                 dimension_numbers=('NWC', 'WIO', 'NWC'), feature_group_count=C)
    return y + b


def mlstm_chunkwise(q, k, v, log_i, log_f):
    B, H, S, Dh = q.shape
    L = MLSTM_CHUNK
    nc = S // L

    def to_chunks(t):
        return jnp.moveaxis(t.reshape(t.shape[:2] + (nc, L) + t.shape[3:]), 2, 0)

    causal = jnp.tril(jnp.ones((L, L), bool))

    def step(carry, inp):
        C, n, m = carry
        qc, kc, vc, ic, fc = inp
        b = jnp.cumsum(fc, axis=-1)
        d = jnp.where(causal, b[..., :, None] - b[..., None, :] + ic[..., None, :], -jnp.inf)
        a = b + m[..., None]
        m_t = jnp.maximum(a, d.max(-1))
        w_intra = jnp.exp(d - m_t[..., None])
        w_inter = jnp.exp(a - m_t)
        s = jnp.einsum('bhtd,bhsd->bhts', qc, kc) * w_intra
        num = jnp.einsum('bhts,bhsd->bhtd', s, vc) + w_inter[..., None] * jnp.einsum('bhvd,bhtd->bhtv', C, qc)
        den = s.sum(-1) + w_inter * jnp.einsum('bhd,bhtd->bht', n, qc)
        h = num / jnp.maximum(jnp.abs(den), jnp.exp(-m_t))[..., None]
        b_last = b[..., -1]
        w_s = b_last[..., None] - b + ic
        m_new = jnp.maximum(b_last + m, w_s.max(-1))
        decay = jnp.exp(b_last + m - m_new)
        w_s = jnp.exp(w_s - m_new[..., None])
        C_new = decay[..., None, None] * C + jnp.einsum('bhs,bhsv,bhsd->bhvd', w_s, vc, kc)
        n_new = decay[..., None] * n + jnp.einsum('bhs,bhsd->bhd', w_s, kc)
        return (C_new, n_new, m_new), h

    init = (jnp.zeros((B, H, Dh, Dh), jnp.float32), jnp.zeros((B, H, Dh), jnp.float32),
            jnp.zeros((B, H), jnp.float32))
    _, hs = lax.scan(step, init, (to_chunks(q), to_chunks(k), to_chunks(v), to_chunks(log_i), to_chunks(log_f)))
    return jnp.moveaxis(hs, 0, 2).reshape(B, H, S, Dh)


def mlstm_layer(h, w_in, conv_w, conv_b, wq, wk, wv, w_if, b_if, gn_g, skip, w_out):
    B, S, _ = h.shape
    NH, DH = MLSTM_HEADS, MLSTM_HEAD_DIM
    f32 = jnp.float32
    xm, z = jnp.split(h @ w_in, 2, axis=-1)
    xc = jax.nn.silu(causal_conv(xm, conv_w, conv_b))
    xc_h = xc.reshape(B, S, NH, DH)
    xm_h = xm.reshape(B, S, NH, DH)
    q = jnp.einsum('bshd,hde->bhse', xc_h, wq).astype(f32)
    k = (jnp.einsum('bshd,hde->bhse', xc_h, wk) * (DH ** -0.5)).astype(f32)
    v = jnp.einsum('bshd,hde->bhse', xm_h, wv).astype(f32)
    gates = jnp.transpose((xc @ w_if + b_if).astype(f32), (0, 2, 1))
    log_i = gates[:, :NH]
    log_f = jax.nn.log_sigmoid(gates[:, NH:])
    hh = mlstm_chunkwise(q, k, v, log_i, log_f)
    mu = hh.mean(-1, keepdims=True)
    var = jnp.square(hh - mu).mean(-1, keepdims=True)
    hh = (hh - mu) * lax.rsqrt(var + LN_EPS)
    hh = hh.transpose(0, 2, 1, 3).reshape(B, S, MLSTM_INNER).astype(h.dtype) * gn_g
    hh = (hh + skip * xc) * jax.nn.silu(z)
    return hh @ w_out


def shared_kv(x, shift, scale, w_kv):
    B, S, D = x.shape
    k, v = jnp.split(modulate(x, shift, scale) @ w_kv, 2, axis=-1)
    s_pad = -(-S // MOBA_BLOCK) * MOBA_BLOCK
    nblk = s_pad // MOBA_BLOCK

    def to_blocks(t):
        t = t.reshape(B, S, ATTN_HEADS, ATTN_HEAD_DIM).transpose(0, 2, 1, 3)
        t = jnp.pad(t, ((0, 0), (0, 0), (0, s_pad - S), (0, 0)))
        return t.reshape(B, ATTN_HEADS, nblk, MOBA_BLOCK, ATTN_HEAD_DIM)

    k_blocks, v_blocks = to_blocks(k), to_blocks(v)
    k_means = k_blocks.astype(jnp.float32).mean(3).astype(k.dtype)
    return k_blocks, v_blocks, k_means


def alibi_slopes(n_heads):
    return jnp.exp2(-8.0 * (jnp.arange(n_heads, dtype=jnp.float32) + 1.0) / n_heads)


def moba_attention(q, k_blocks, v_blocks, k_means, slopes):
    B, H, S, Dh = q.shape
    nblk = k_blocks.shape[2]
    topk = min(MOBA_TOPK, nblk)
    QC, BLK = MOBA_QCHUNK, MOBA_BLOCK
    nq = S // QC
    q_chunks = jnp.moveaxis(q.reshape(B, H, nq, QC, Dh), 2, 0)
    bi = jnp.arange(B)[:, None, None, None]
    hi = jnp.arange(H)[None, :, None, None]
    blk_ids = jnp.arange(nblk)
    offs = jnp.arange(BLK)
    f32 = jnp.float32

    def one_chunk(args):
        ci, qc = args
        t = ci * QC + jnp.arange(QC)
        own = (ci * QC) // BLK
        gate = jnp.einsum('bhtd,bhnd->bhtn', qc, k_means).astype(f32)
        gate = jnp.where(blk_ids < own, gate, -jnp.inf)
        _, sel = lax.top_k(gate, topk)
        valid = sel < own
        k_sel = k_blocks[bi, hi, sel]
        v_sel = v_blocks[bi, hi, sel].reshape(B, H, QC, topk * BLK, Dh)
        s_sel = jnp.einsum('bhtd,bhtjsd->bhtjs', qc, k_sel).astype(f32)
        pos_sel = sel[..., None] * BLK + offs
        dist_sel = (t[:, None, None] - pos_sel).astype(f32)
        s_sel = s_sel - slopes[:, None, None, None] * dist_sel
        s_sel = jnp.where(valid[..., None], s_sel, -jnp.inf).reshape(B, H, QC, topk * BLK)
        k_own = lax.dynamic_index_in_dim(k_blocks, own, axis=2, keepdims=False)
        v_own = lax.dynamic_index_in_dim(v_blocks, own, axis=2, keepdims=False)
        s_own = jnp.einsum('bhtd,bhsd->bhts', qc, k_own).astype(f32)
        pos_own = own * BLK + offs
        dist_own = (t[:, None] - pos_own[None, :]).astype(f32)
        s_own = jnp.where(dist_own >= 0, s_own - slopes[:, None, None] * dist_own, -jnp.inf)
        p = jax.nn.softmax(jnp.concatenate([s_sel, s_own], axis=-1), axis=-1).astype(v_blocks.dtype)
        return (jnp.einsum('bhts,bhtsd->bhtd', p[..., :topk * BLK], v_sel)
                + jnp.einsum('bhts,bhsd->bhtd', p[..., topk * BLK:], v_own))

    outs = lax.map(one_chunk, (jnp.arange(nq), q_chunks))
    return jnp.moveaxis(outs, 0, 2).reshape(B, H, S, Dh)


def moba_layer(h, wq, wo, k_blocks, v_blocks, k_means, slopes):
    B, S, D = h.shape
    q = (h @ wq).reshape(B, S, ATTN_HEADS, ATTN_HEAD_DIM).transpose(0, 2, 1, 3) * (ATTN_HEAD_DIM ** -0.5)
    o = moba_attention(q, k_blocks, v_blocks, k_means, slopes)
    return o.transpose(0, 2, 1, 3).reshape(B, S, D) @ wo


def route(x2, w_router, b_router):
    T = x2.shape[0]
    probs = jax.nn.softmax((x2 @ w_router).astype(jnp.float32), axis=-1)
    sel_scores = (probs + b_router).reshape(T, N_GROUPS, EXPERTS_PER_GROUP)
    grp_score = lax.top_k(sel_scores, MOE_TOPK)[0].sum(-1)
    g = jnp.argmax(grp_score, axis=-1)
    masked = jnp.where(jnp.arange(N_GROUPS)[None, :, None] == g[:, None, None], sel_scores, -jnp.inf)
    _, idx = lax.top_k(masked.reshape(T, N_EXPERTS), MOE_TOPK)
    w = jnp.take_along_axis(probs, idx, axis=-1)
    return idx, w / w.sum(-1, keepdims=True)


def moe_ffn(h, w_router, b_router, w_gate, w_up, w_down):
    B, S, D = h.shape
    T = B * S
    x2 = h.reshape(T, D)
    idx, wts = route(x2, w_router, b_router)
    n_assign = T * MOE_TOPK
    e_flat = idx.reshape(-1)
    tok_flat = jnp.repeat(jnp.arange(T, dtype=jnp.int32), MOE_TOPK)
    w_flat = wts.reshape(-1)
    order = jnp.argsort(e_flat)
    e_sorted = e_flat[order]
    counts = jnp.zeros((N_EXPERTS,), jnp.int32).at[e_flat].add(1)
    starts = jnp.cumsum(counts) - counts
    padded = (counts + MOE_ROW_BLOCK - 1) // MOE_ROW_BLOCK * MOE_ROW_BLOCK
    pends = jnp.cumsum(padded)
    pstarts = pends - padded
    dest = pstarts[e_sorted] + (jnp.arange(n_assign, dtype=jnp.int32) - starts[e_sorted])
    n_blocks = -(-n_assign // MOE_ROW_BLOCK) + N_EXPERTS
    cap = n_blocks * MOE_ROW_BLOCK
    buf_tok = jnp.zeros((cap,), jnp.int32).at[dest].set(tok_flat[order])
    buf_w = jnp.zeros((cap,), jnp.float32).at[dest].set(w_flat[order])
    block_start = jnp.arange(n_blocks, dtype=jnp.int32) * MOE_ROW_BLOCK
    block_expert = jnp.minimum(jnp.searchsorted(pends, block_start, side='right'), N_EXPERTS - 1)
    xs = x2[buf_tok].reshape(n_blocks, MOE_ROW_BLOCK, D)

    def expert_block(args):
        xb, e = args
        return (jax.nn.silu(xb @ w_gate[e]) * (xb @ w_up[e])) @ w_down[e]

    ys = lax.map(expert_block, (xs, block_expert)).reshape(cap, D)
    y = jnp.zeros((T, D), h.dtype).at[buf_tok].add(ys * buf_w[:, None].astype(ys.dtype))
    return y.reshape(B, S, D)


def setup_inputs(seed: int = 0) -> dict:
    key = jax.random.key(seed)
    ks = jax.random.split(key, 27)
    D, DI, NH, DH = D_MODEL, MLSTM_INNER, MLSTM_HEADS, MLSTM_HEAD_DIM
    nA, nB = N_A_LAYERS, N_B_LAYERS

    def nrm(k, shape, s):
        return jax.random.normal(k, shape, jnp.float32) * s

    n_mod = DEPTH * N_MOD_PER_LAYER * D + 2 * D
    x = nrm(ks[0], (BATCH, SEQ, D), 1.0)
    c = nrm(ks[1], (BATCH, D), 1.0)
    w_ada = nrm(ks[2], (D, n_mod), 0.1 * D ** -0.5)
    b_ada = nrm(ks[3], (n_mod,), 0.01)
    ln_g = 1.0 + nrm(ks[4], (DEPTH, 2, D), 0.02)
    ln_b = nrm(ks[5], (DEPTH, 2, D), 0.02)
    a_w_in = nrm(ks[6], (nA, D, 2 * DI), D ** -0.5)
    a_conv_w = nrm(ks[7], (nA, CONV_WIDTH, DI), CONV_WIDTH ** -0.5)
    a_conv_b = nrm(ks[8], (nA, DI), 0.01)
    a_wq = nrm(ks[9], (nA, NH, DH, DH), DH ** -0.5)
    a_wk = nrm(ks[10], (nA, NH, DH, DH), DH ** -0.5)
    a_wv = nrm(ks[11], (nA, NH, DH, DH), DEEPNORM_BETA * DH ** -0.5)
    a_w_if = nrm(ks[12], (nA, DI, 2 * NH), 0.1 * DI ** -0.5)
    a_b_if = jnp.concatenate([nrm(ks[13], (nA, NH), 0.1),
                              jnp.linspace(3.0, 6.0, NH) + nrm(ks[14], (nA, NH), 0.1)], axis=-1)
    a_gn_g = 1.0 + nrm(ks[15], (nA, DI), 0.02)
    a_skip = 1.0 + nrm(ks[16], (nA, DI), 0.02)
    a_w_out = nrm(ks[17], (nA, DI, D), DEEPNORM_BETA * DI ** -0.5)
    b_w_kv = jnp.concatenate([nrm(ks[18], (D, D), D ** -0.5),
                              nrm(ks[19], (D, D), DEEPNORM_BETA * D ** -0.5)], axis=-1)
    b_wq = nrm(ks[20], (nB, D, D), D ** -0.5)
    b_wo = nrm(ks[21], (nB, D, D), DEEPNORM_BETA * D ** -0.5)
    moe_w_router = nrm(ks[22], (D, N_EXPERTS), D ** -0.5)
    moe_b_router = nrm(ks[23], (N_EXPERTS,), 0.01)
    moe_w_gate = nrm(ks[24], (DEPTH, N_EXPERTS, D, D_FF_EXPERT), D ** -0.5)
    moe_w_up = nrm(ks[25], (DEPTH, N_EXPERTS, D, D_FF_EXPERT), D ** -0.5)
    moe_w_down = nrm(ks[26], (DEPTH, N_EXPERTS, D_FF_EXPERT, D), DEEPNORM_BETA * D_FF_EXPERT ** -0.5)
    return {'x': x, 'c': c, 'w_ada': w_ada, 'b_ada': b_ada, 'ln_g': ln_g, 'ln_b': ln_b,
            'a_w_in': a_w_in, 'a_conv_w': a_conv_w, 'a_conv_b': a_conv_b, 'a_wq': a_wq, 'a_wk': a_wk,
            'a_wv': a_wv, 'a_w_if': a_w_if, 'a_b_if': a_b_if, 'a_gn_g': a_gn_g, 'a_skip': a_skip,
            'a_w_out': a_w_out, 'b_w_kv': b_w_kv, 'b_wq': b_wq, 'b_wo': b_wo,
            'moe_w_router': moe_w_router, 'moe_b_router': moe_b_router, 'moe_w_gate': moe_w_gate,
            'moe_w_up': moe_w_up, 'moe_w_down': moe_w_down}


def reference(x, c, w_ada, b_ada, ln_g, ln_b, a_w_in, a_conv_w, a_conv_b, a_wq, a_wk, a_wv, a_w_if,
              a_b_if, a_gn_g, a_skip, a_w_out, b_w_kv, b_wq, b_wo, moe_w_router, moe_b_router,
              moe_w_gate, moe_w_up, moe_w_down):
    B, S, D = x.shape
    n_layer_mod = DEPTH * N_MOD_PER_LAYER * D
    cond = jax.nn.silu(c) @ w_ada + b_ada
    mods = cond[:, :n_layer_mod].reshape(B, DEPTH, 2, 3, D)
    kv_mod = cond[:, n_layer_mod:].reshape(B, 2, D)
    slopes = alibi_slopes(ATTN_HEADS)
    kv = None
    for layer in range(DEPTH):
        shift, scale, gate = mods[:, layer, 0, 0], mods[:, layer, 0, 1], 1.0 + mods[:, layer, 0, 2]
        h = modulate(x, shift, scale)
        if layer < N_A_LAYERS:
            i = layer
            y = mlstm_layer(h, a_w_in[i], a_conv_w[i], a_conv_b[i], a_wq[i], a_wk[i], a_wv[i], a_w_if[i],
                            a_b_if[i], a_gn_g[i], a_skip[i], a_w_out[i])
        else:
            if kv is None:
                kv = shared_kv(x, kv_mod[:, 0], kv_mod[:, 1], b_w_kv)
            j = layer - N_A_LAYERS
            y = moba_layer(h, b_wq[j], b_wo[j], kv[0], kv[1], kv[2], slopes)
        x = layer_norm(DEEPNORM_ALPHA * x + gate[:, None, :] * y, ln_g[layer, 0], ln_b[layer, 0])
        shift, scale, gate = mods[:, layer, 1, 0], mods[:, layer, 1, 1], 1.0 + mods[:, layer, 1, 2]
        h = modulate(x, shift, scale)
        y = moe_ffn(h, moe_w_router, moe_b_router, moe_w_gate[layer], moe_w_up[layer], moe_w_down[layer])
        x = layer_norm(DEEPNORM_ALPHA * x + gate[:, None, :] * y, ln_g[layer, 1], ln_b[layer, 1])
    return x
```

```cpp
#include <hip/hip_runtime.h>
#include <cstdio>
#include <cstdint>
#include <cmath>
namespace pg8 {
#define PG8_LAS __attribute__((address_space(3)))
#define PG8_LAS_T __attribute__((address_space(3)))
typedef unsigned short bf16_t;
typedef short bf16x8 __attribute__((ext_vector_type(8)));
typedef float f32x4 __attribute__((ext_vector_type(4)));
typedef float f32x2 __attribute__((ext_vector_type(2)));
typedef unsigned u32x4 __attribute__((ext_vector_type(4)));
typedef unsigned u32x2 __attribute__((ext_vector_type(2)));
constexpr int BM = 256, BK = 64, HALF = 128, HTB = HALF * BK * 2  , STAGE_BYTES = 8 * HTB;

__host__ __device__ __forceinline__ int lds_byte(int r, int c) { const int st = (r >> 4) * 2 + (c >> 5), rr = r & 15, cc = c & 31, ob = rr * 64 + cc * 2; return st * 1024 + (ob ^ (((ob >> 9) & 1) << 5)); }
__host__ __device__ __forceinline__ void stage_rc(int b, int& R, int& C) { const int st = b / 1024, sb = b % 1024, swz = sb ^ (((sb >> 9) & 1) << 5); R = (st >> 1) * 16 + swz / 64; C = (st & 1) * 32 + (swz % 64) / 2; }
__host__ __device__ __forceinline__ int perm32(int rho) { const int n = rho >> 4, i = rho & 15; return 8 * (i >> 2) + 4 * n + (i & 3); }

typedef __bf16 bf16x2_t __attribute__((ext_vector_type(2)));
__device__ __forceinline__ unsigned cvt_pk_bf16(float lo, float hi) { f32x2 v = {lo, hi}; bf16x2_t b = __builtin_convertvector(v, bf16x2_t); return __builtin_bit_cast(unsigned, b); }

template <class Epi, class Sched, bool ALIGN_EPI, bool SP2, bool GATHER = false>
__device__ __forceinline__ void gemm_phase(PG8_LAS unsigned char* lds, const int wid, const int lda, const int ldb, const int K, const Sched& S, const Epi& E, PG8_LAS int* tokTab = nullptr) {
    unsigned ones_ = ~0u; asm volatile("" : "+s"(ones_));
    const int lane = __builtin_amdgcn_mbcnt_hi(ones_, __builtin_amdgcn_mbcnt_lo(ones_, 0u));
    const int tid = wid * 64 + lane, wr = wid >> 2, wc = wid & 3, fr = lane & 15, fq = lane >> 4;
    const int nt = K / BK;
    unsigned voffA[2], voffA1[2], voffB[2]; int gR[2], gC[2];
#pragma unroll
    for (int i = 0; i < 2; ++i) { int R, C; stage_rc(tid * 16 + i * 8192, R, C); const int Rb = Epi::PERM ? ((R & ~31) + perm32(R & 31)) : R; gR[i] = R; gC[i] = C;
        voffA[i] = (unsigned)(R * lda + C) * 2u; voffA1[i] = voffA[i]; voffB[i] = (unsigned)(Rb * ldb + C) * 2u; }
    const size_t kstep = (size_t)(BK * 2);
    const size_t hstepA = GATHER ? (size_t)0 : (size_t)HALF * lda * 2, hstepB = (size_t)HALF * ldb * 2;
#define PG8_GOFF(slot) do { _Pragma("unroll") for (int _i = 0; _i < 2; ++_i) { \
        voffA[_i] = ((unsigned)tokTab[(slot) * 256 + gR[_i]] * (unsigned)lda + (unsigned)gC[_i]) * 2u; voffA1[_i] = ((unsigned)tokTab[(slot) * 256 + 128 + gR[_i]] * (unsigned)lda + (unsigned)gC[_i]) * 2u; } } while (0)
    const unsigned ldsw = (unsigned)wid * 1024u;
    const int aoff = lds_byte(wr * 64 + fr, fq * 8), boff = lds_byte(wc * 32 + fr, fq * 8);
#define PG8_SA(b, h) (((b) * 2 + (h)) * HTB)
#define PG8_SB(b, h) ((4 + (b) * 2 + (h)) * HTB)
#define PG8_STAGE(bufoff, gbase, voff) do { _Pragma("unroll") for (int _i = 0; _i < 2; ++_i) \
        __builtin_amdgcn_global_load_lds((const unsigned*)((const char*)(gbase) + (voff)[_i]), (PG8_LAS unsigned*)(lds + (bufoff) + ldsw + _i * 8192), 16, 0, 0); } while (0)
#define PG8_LDA(dst, b, h) do { _Pragma("unroll") for (int m = 0; m < 4; ++m) _Pragma("unroll") for (int k = 0; k < 2; ++k) dst[m][k] = *(const PG8_LAS bf16x8*)(lds + PG8_SA(b, h) + aoff + m * 2048 + k * 1024); } while (0)
#define PG8_LDB(dst, b, h) do { _Pragma("unroll") for (int n = 0; n < 2; ++n) _Pragma("unroll") for (int k = 0; k < 2; ++k) dst[n][k] = *(const PG8_LAS bf16x8*)(lds + PG8_SB(b, h) + boff + n * 2048 + k * 1024); } while (0)
#define PG8_MMA(ai, bj, At, Bt) do { __builtin_amdgcn_s_setprio(1); _Pragma("unroll") for (int m = 0; m < 4; ++m) _Pragma("unroll") for (int n = 0; n < 2; ++n) _Pragma("unroll") for (int k = 0; k < 2; ++k) \
        acc[ai][bj][m][n] = __builtin_amdgcn_mfma_f32_16x16x32_bf16(Bt[n][k], At[m][k], acc[ai][bj][m][n], 0, 0, 0); __builtin_amdgcn_s_setprio(0); } while (0)
#define PG8_WAIT_V(n) asm volatile("s_waitcnt vmcnt(" #n ")" ::: "memory")
#define PG8_WAIT_L(n) asm volatile("s_waitcnt lgkmcnt(" #n ")" ::: "memory")
#define PG8_BAR __builtin_amdgcn_s_barrier()
#define PG8_SCHED __builtin_amdgcn_sched_barrier(0)
    const char* cA; const char* cB; const char* nA; const char* nB; int ui = 0;
    if (!S.next(0, cA, cB)) return;
    if constexpr (GATHER) { S.load_tokens(0, tokTab, tid); asm volatile("s_waitcnt vmcnt(0) lgkmcnt(0)" ::: "memory"); __builtin_amdgcn_s_barrier(); PG8_GOFF(0); }
    f32x4 acc[2][2][4][2];
#pragma unroll
    for (int a = 0; a < 2; ++a)
#pragma unroll
        for (int b = 0; b < 2; ++b)
#pragma unroll
            for (int m = 0; m < 4; ++m)
#pragma unroll
                for (int n = 0; n < 2; ++n) acc[a][b][m][n] = (f32x4){0.f, 0.f, 0.f, 0.f};
    bf16x8 At[4][2], B0[2][2], B1[2][2];
    if constexpr (SP2) {
        PG8_STAGE(PG8_SB(0, 0), cB, voffB); PG8_STAGE(PG8_SB(0, 1), cB + hstepB, voffB); PG8_STAGE(PG8_SA(0, 0), cA, voffA); PG8_STAGE(PG8_SA(0, 1), cA + hstepA, voffA1);
        if (wr == 1) PG8_BAR;
        PG8_WAIT_V(2); PG8_BAR;
        PG8_STAGE(PG8_SB(1, 0), cB + kstep, voffB); PG8_STAGE(PG8_SA(1, 0), cA + kstep, voffA); PG8_STAGE(PG8_SB(1, 1), cB + hstepB + kstep, voffB);
        PG8_WAIT_V(6); PG8_BAR;
    } else {
        PG8_STAGE(PG8_SB(0, 0), cB, voffB); PG8_STAGE(PG8_SA(0, 0), cA, voffA); PG8_STAGE(PG8_SB(0, 1), cB + hstepB, voffB); PG8_STAGE(PG8_SA(0, 1), cA + hstepA, voffA1);
        if (wr == 1) PG8_BAR;
        PG8_WAIT_V(4); PG8_BAR;
        PG8_STAGE(PG8_SB(1, 0), cB + kstep, voffB); PG8_STAGE(PG8_SA(1, 0), cA + kstep, voffA); PG8_STAGE(PG8_SB(1, 1), cB + hstepB + kstep, voffB);
        PG8_WAIT_V(6); PG8_BAR;
    }
    for (;;) {
        const bool has_next = S.next(ui + 1, nA, nB);
        if (!has_next) { nA = cA; nB = cB; }
        if constexpr (GATHER) { if (has_next) S.load_tokens(ui + 1, tokTab + ((ui + 1) & 1) * 256, tid); }
        _Pragma("unroll 1") for (int t = 0; t < nt; t += 2) {
            const bool last = (t == nt - 2);
            const char* a1 = cA + (size_t)(t + 1) * kstep;
            const char* a2 = last ? nA : cA + (size_t)(t + 2) * kstep; const char* b2 = last ? nB : cB + (size_t)(t + 2) * kstep;
            const char* a3 = a2 + kstep; const char* b3 = b2 + kstep;
            if constexpr (SP2) {
            PG8_LDB(B0, 0, 0); PG8_LDB(B1, 0, 1); PG8_SCHED; PG8_LDA(At, 0, 0); PG8_STAGE(PG8_SA(1, 1), a1 + hstepA, voffA1);
            if constexpr (GATHER) { if (last && has_next) { PG8_SCHED; PG8_GOFF((ui + 1) & 1); } }
            PG8_WAIT_V(8); PG8_WAIT_L(0); PG8_BAR; PG8_MMA(0, 0, At, B0); PG8_MMA(0, 1, At, B1); PG8_BAR; PG8_SCHED;
            PG8_LDA(At, 0, 1); PG8_STAGE(PG8_SB(0, 0), b2, voffB); PG8_STAGE(PG8_SB(0, 1), b2 + hstepB, voffB); PG8_STAGE(PG8_SA(0, 0), a2, voffA);
            PG8_WAIT_V(8); PG8_WAIT_L(0); PG8_BAR; PG8_MMA(1, 0, At, B0); PG8_MMA(1, 1, At, B1); PG8_BAR; PG8_SCHED;
            PG8_LDB(B0, 1, 0); PG8_LDB(B1, 1, 1); PG8_SCHED; PG8_LDA(At, 1, 0); PG8_STAGE(PG8_SA(0, 1), a2 + hstepA, voffA1);
            PG8_WAIT_V(8); PG8_WAIT_L(0); PG8_BAR; PG8_MMA(0, 0, At, B0); PG8_MMA(0, 1, At, B1); PG8_BAR; PG8_SCHED;
            PG8_LDA(At, 1, 1); PG8_STAGE(PG8_SB(1, 0), b3, voffB); PG8_STAGE(PG8_SB(1, 1), b3 + hstepB, voffB); PG8_STAGE(PG8_SA(1, 0), a3, voffA);
            PG8_WAIT_V(8); PG8_WAIT_L(0); PG8_BAR; PG8_MMA(1, 0, At, B0); PG8_MMA(1, 1, At, B1); PG8_BAR; PG8_SCHED;
            } else {
            PG8_LDB(B0, 0, 0); PG8_SCHED; PG8_LDA(At, 0, 0); PG8_STAGE(PG8_SA(1, 1), a1 + hstepA, voffA1);
            PG8_WAIT_L(8); PG8_BAR; PG8_WAIT_L(0); PG8_MMA(0, 0, At, B0); PG8_BAR; PG8_SCHED;
            PG8_LDB(B1, 0, 1); PG8_STAGE(PG8_SB(0, 0), b2, voffB);
            PG8_BAR; PG8_WAIT_L(0); PG8_MMA(0, 1, At, B1); PG8_BAR;
            PG8_LDA(At, 0, 1); PG8_STAGE(PG8_SA(0, 0), a2, voffA);
            PG8_BAR; PG8_WAIT_L(0); PG8_MMA(1, 0, At, B0); PG8_BAR; PG8_SCHED;
            PG8_STAGE(PG8_SB(0, 1), b2 + hstepB, voffB);
            PG8_WAIT_V(6); PG8_BAR; PG8_MMA(1, 1, At, B1); PG8_BAR;
            PG8_LDB(B0, 1, 0); PG8_SCHED; PG8_LDA(At, 1, 0); PG8_STAGE(PG8_SA(0, 1), a2 + hstepA, voffA1);
            PG8_WAIT_L(8); PG8_BAR; PG8_WAIT_L(0); PG8_MMA(0, 0, At, B0); PG8_BAR; PG8_SCHED;
            PG8_LDB(B1, 1, 1); PG8_STAGE(PG8_SB(1, 0), b3, voffB);
            PG8_BAR; PG8_WAIT_L(0); PG8_MMA(0, 1, At, B1); PG8_BAR;
            PG8_LDA(At, 1, 1); PG8_STAGE(PG8_SA(1, 0), a3, voffA);
            PG8_BAR; PG8_WAIT_L(0); PG8_MMA(1, 0, At, B0); PG8_BAR; PG8_SCHED;
            PG8_STAGE(PG8_SB(1, 1), b3 + hstepB, voffB);
            PG8_WAIT_V(6); PG8_BAR; PG8_MMA(1, 1, At, B1); PG8_BAR;
            }
        }
        if constexpr (ALIGN_EPI) { if (wr == 0) PG8_BAR; }
        E(acc, ui, wr, wc, fr, fq);
        if (!has_next) break;
#pragma unroll
        for (int a = 0; a < 2; ++a)
#pragma unroll
            for (int b = 0; b < 2; ++b)
#pragma unroll
                for (int m = 0; m < 4; ++m)
#pragma unroll
                    for (int n = 0; n < 2; ++n) acc[a][b][m][n] = (f32x4){0.f, 0.f, 0.f, 0.f};
        cA = nA; cB = nB; ++ui;
        if constexpr (ALIGN_EPI) { if (wr == 1) PG8_BAR; }
    }
    PG8_WAIT_V(0);
    if constexpr (!ALIGN_EPI) { if (wr == 0) PG8_BAR; }
    PG8_BAR;
#undef PG8_GOFF
#undef PG8_SA
#undef PG8_SB
#undef PG8_STAGE
#undef PG8_LDA
#undef PG8_LDB
#undef PG8_MMA
#undef PG8_WAIT_V
#undef PG8_WAIT_L
#undef PG8_BAR
#undef PG8_SCHED
}
}
constexpr int NWAVES = 8, NTHR = 512;
constexpr int BATCH = 2, SEQ = 8192, DM = 1024, M = BATCH * SEQ;
constexpr int DI = 2048, NH = 4, DH = 512, LCH = 256, NCH = SEQ / LCH;
constexpr int AH = 16, HD = 64, MBLK = 256, NBLK = SEQ / MBLK;
constexpr int NE = 16, DFF = 512;
constexpr int NMOD = 2 * 6 * DM + 2 * DM;
constexpr float LN_EPS = 1e-5f;
constexpr float DN_ALPHA = 1.4142135623730951f;
constexpr float LOG2E = 1.4426950408889634f;

constexpr size_t MiB = 1u << 20;
constexpr size_t WS_CTL = 0, CTL_ZERO_BYTES = 256 * 1024;
constexpr size_t WS_SMALL = 4 * MiB;
constexpr size_t WS_WIN = 8 * MiB;
constexpr size_t WS_WQKV = 16 * MiB;
constexpr size_t WS_WOUT = 22 * MiB;
constexpr size_t WS_WKV = 26 * MiB;
constexpr size_t WS_WQ1 = 30 * MiB;
constexpr size_t WS_WO1 = 32 * MiB;
constexpr size_t WS_ARENA = 36 * MiB;
constexpr size_t WS_END = 364 * MiB;
constexpr size_t WS_XC = 36 * MiB;
constexpr size_t WS_H0 = 100 * MiB;
constexpr size_t WS_XM = 132 * MiB;
constexpr size_t WS_AQ = 196 * MiB;
constexpr size_t WS_BC = 244 * MiB;
constexpr size_t WS_HHB = 196 * MiB;
constexpr size_t WS_MOEW0 = 300 * MiB;
constexpr size_t WS_U0 = 36 * MiB;
constexpr size_t WS_X1 = 108 * MiB;
constexpr size_t WS_HMOE0 = 172 * MiB;
constexpr size_t WS_XG0 = 204 * MiB;
constexpr size_t WS_YS0 = 36 * MiB;
constexpr size_t WS_X2 = 300 * MiB;
constexpr size_t WS_H1 = 300 * MiB;
constexpr size_t WS_HKV = 332 * MiB;
constexpr size_t WS_VT1 = 36 * MiB;
constexpr size_t WS_MOEW1 = 108 * MiB;
constexpr size_t WS_LISTS = 68 * MiB;
constexpr size_t WS_PART = 156 * MiB;
constexpr size_t WS_LSE = 284 * MiB;
constexpr size_t WS_OB = 68 * MiB;
constexpr size_t WS_X3 = 156 * MiB;
constexpr size_t WS_HMOE1 = 220 * MiB;
constexpr size_t WS_XG1 = 252 * MiB;
constexpr size_t WS_ACT1 = 36 * MiB;
constexpr size_t WS_YS1 = 252 * MiB;

constexpr int CW_TMO = 0;
constexpr int CW_DBG = 8;
constexpr int CW_BAR = 4096;
constexpr int CW_MOECNT = 8192;
constexpr int CW_LCNT = 16384;
constexpr int CW_COND = 65536;
constexpr int CW_KNP = 98304;
constexpr int CW_KN = 130048;
constexpr int CW_KM = 131072;
constexpr int CW_DENI = 262144;
constexpr int CW_DN = 524288;
static_assert((CW_DN + 524288) * 4 <= (int)(4 * MiB), "CTL map");
constexpr size_t WS_HSTAT = 348 * MiB;
constexpr int SW_G = 0;
constexpr int SW_WK = 131072;
constexpr int SW_CS = 196608;
constexpr int SW_EA = 262144;
constexpr int SW_DENF = 327680;
constexpr int SW_DEC = 393216;
constexpr int SW_IDX = 397312;
constexpr int SW_WTS = 430080;
constexpr int SW_POS = 462848;
constexpr int BT_CAP = 16384;
constexpr int SW_BT = 495616;
static_assert((SW_BT + 16 * BT_CAP) * 4 <= (int)(4 * MiB), "SMALL map");

constexpr int RING_OFF = 0, RING_BYTES = 131072;
constexpr int LDSCTL_OFF = RING_BYTES, MISC_OFF = LDSCTL_OFF + 320;
constexpr int LDS_BYTES = 147456;

#define GAS __attribute__((address_space(1)))
#define LAS __attribute__((address_space(3)))
typedef unsigned short bf16;
typedef unsigned v4u __attribute__((ext_vector_type(4)));
typedef unsigned v2u __attribute__((ext_vector_type(2)));
typedef float f32x4 __attribute__((ext_vector_type(4)));
typedef float f32x16 __attribute__((ext_vector_type(16)));
typedef short bf16x8 __attribute__((ext_vector_type(8)));
typedef GAS unsigned gu32;
#define RLX_AGENT __ATOMIC_RELAXED, __HIP_MEMORY_SCOPE_AGENT
#define LDS_WAIT() asm volatile("s_waitcnt lgkmcnt(0)" ::: "memory")
#define VM_WAIT() asm volatile("s_waitcnt vmcnt(0)" ::: "memory")
__device__ __forceinline__ unsigned f2bf(float f) { unsigned u = __builtin_bit_cast(unsigned, f); return (u + 0x7fffu + ((u >> 16) & 1u)) >> 16; }
__device__ __forceinline__ unsigned pk2(float lo, float hi) { return f2bf(lo) | (f2bf(hi) << 16); }
__device__ __forceinline__ float bf2f(unsigned short h) { return __builtin_bit_cast(float, (unsigned)h << 16); }
__device__ __forceinline__ float bflo(unsigned w) { return __builtin_bit_cast(float, w << 16); }
__device__ __forceinline__ float bfhi(unsigned w) { return __builtin_bit_cast(float, w & 0xffff0000u); }
__device__ __forceinline__ float silu_f(float v) { return v * __builtin_amdgcn_rcpf(1.f + __builtin_amdgcn_exp2f(v * -1.44269504f)); }
__device__ __forceinline__ float wave_sum(float v) {
#pragma unroll
    for (int o = 1; o < 64; o <<= 1) v += __shfl_xor(v, o);
    return v;
}
template <int CTRL, int ROWMASK> __device__ __forceinline__ float dpp_add(float v) {
    const int t = __builtin_amdgcn_update_dpp(0, __builtin_bit_cast(int, v), CTRL, ROWMASK, 0xF, false);
    return v + __builtin_bit_cast(float, t);
}
__device__ __forceinline__ float wave_sum_dpp(float v) {
    v = dpp_add<0xB1, 0xF>(v);
    v = dpp_add<0x4E, 0xF>(v);
    v = dpp_add<0x141, 0xF>(v);
    v = dpp_add<0x140, 0xF>(v);
    v = dpp_add<0x142, 0xA>(v);
    v = dpp_add<0x143, 0xC>(v);
    return __builtin_bit_cast(float, __builtin_amdgcn_readlane(__builtin_bit_cast(int, v), 63));
}

#define XB_TMO      128
#define XB_XCNT(j)  (256  + 64 * (j))
#define XB_XSUB(j)  (1280 + 64 * (j))
#define XB_XGEN(j)  (2304 + 64 * (j))
#define XB_TOP      3328
#define XB_TOPGEN   3392
#define XCD_BAR_WORDS 3456
#define XB_SPIN_CAP (1u << 22)

__device__ __forceinline__ unsigned xb_ld(unsigned* p)              { return __hip_atomic_load(p, __ATOMIC_RELAXED, __HIP_MEMORY_SCOPE_AGENT); }
__device__ __forceinline__ unsigned xb_add(unsigned* p, unsigned v) { return __hip_atomic_fetch_add(p, v, __ATOMIC_RELAXED, __HIP_MEMORY_SCOPE_AGENT); }
__device__ __forceinline__ unsigned xb_xcc_id() { return (unsigned)__builtin_amdgcn_s_getreg((3 << 11) | 20) & 0xFu; }
#define XB_SPIN(cond, bar) do { unsigned _sp = 0; while (cond) { __builtin_amdgcn_s_sleep(1); \
    if ((++_sp & 255u) == 0u) { if (xb_ld(&(bar)[XB_TMO])) break; if (_sp > XB_SPIN_CAP) { atomicAdd(&(bar)[XB_TMO], 1u); break; } } } } while (0)

struct XcdBarrier { unsigned* bar; unsigned x; volatile LAS unsigned* st; };

__device__ __forceinline__ XcdBarrier xcd_barrier_post(unsigned* bar, volatile LAS unsigned* st) {
    XcdBarrier b; b.bar = bar; b.x = xb_xcc_id(); b.st = st;
    if (threadIdx.x == 0) (void)xb_add(&bar[XB_XCNT(b.x)], 1u);
    return b;
}
__device__ __forceinline__ void xcd_barrier_complete(unsigned* bar, unsigned x, unsigned& nloc, unsigned& nx) {
    const unsigned G = gridDim.x * gridDim.y * gridDim.z;
    unsigned sum, cnt, mine, sp = 0u;
    for (;;) {
        sum = 0u; cnt = 0u; mine = 0u;
#pragma unroll
        for (unsigned j = 0; j < 16; ++j) { const unsigned c = xb_ld(&bar[XB_XCNT(j)]); sum += c; cnt += (c > 0u) ? 1u : 0u; mine = (j == x) ? c : mine; }
        if (sum == G) break;
        __builtin_amdgcn_s_sleep(1);
        if ((++sp & 255u) == 0u) { if (xb_ld(&bar[XB_TMO])) break; if (sp > XB_SPIN_CAP) { atomicAdd(&bar[XB_TMO], 1u); break; } }
    }
    nloc = mine > 0u ? mine : 1u; nx = cnt > 0u ? cnt : 1u;
}
__device__ __forceinline__ void xcd_barrier(const XcdBarrier& b) {
    asm volatile("s_waitcnt vmcnt(0)" ::: "memory");
    __syncthreads();
    if (threadIdx.x == 0) {
        unsigned* bar = b.bar;
        __builtin_amdgcn_s_waitcnt(0);
        unsigned nloc = b.st[0], nx = b.st[1];
        if (nloc == 0u) { xcd_barrier_complete(bar, b.x, nloc, nx); b.st[0] = nloc; b.st[1] = nx; }
        const unsigned old = xb_add(&bar[XB_XSUB(b.x)], 1u);
        const unsigned gen = old / nloc;
        if (old + 1u == (gen + 1u) * nloc) {
            __builtin_amdgcn_fence(__ATOMIC_RELEASE, "agent");
            asm volatile("s_waitcnt vmcnt(0)" ::: "memory");
            const unsigned og = xb_add(&bar[XB_TOP], 1u);
            const unsigned tg = og / nx;
            if (og + 1u == (tg + 1u) * nx) xb_add(&bar[XB_TOPGEN], 1u);
            else XB_SPIN(xb_ld(&bar[XB_TOPGEN]) == tg, bar);
            __builtin_amdgcn_fence(__ATOMIC_ACQUIRE, "agent");
            xb_add(&bar[XB_XGEN(b.x)], 1u);
            asm volatile("s_waitcnt vmcnt(0)" ::: "memory");
        } else {
            XB_SPIN(xb_ld(&bar[XB_XGEN(b.x)]) == gen, bar);
            __builtin_amdgcn_fence(__ATOMIC_ACQUIRE, "agent");
            asm volatile("s_waitcnt vmcnt(0)" ::: "memory");
        }
    }
    __syncthreads();
}
struct Args {
    const float* in[25];
    float* out; unsigned char* ws;
    int ph_lo, ph_hi;
};
enum { I_X = 0, I_C, I_WADA, I_BADA, I_LNG, I_LNB, I_AWIN, I_ACONVW, I_ACONVB, I_AWQ, I_AWK, I_AWV, I_AWIF, I_ABIF, I_AGN, I_ASKIP, I_AWOUT,
       I_BWKV, I_BWQ, I_BWO, I_MWR, I_MBR, I_MWG, I_MWU, I_MWD };

typedef const char __attribute__((address_space(4)))* kaptr_t;
struct Frame {
    LAS unsigned char* lds;
    int tid, lane, wave, G, bx;
    kaptr_t ka;
    unsigned char* ws; float* out;
    unsigned* ctl; float* ctlf; float* smallf;
};
#define KIN(F, i) (*(const float* const __attribute__((address_space(4)))*)((F).ka + 8 * (i)))
__device__ __forceinline__ int mod_off(int layer, int sub, int which) { return ((layer * 2 + sub) * 3 + which) * DM; }

__device__ __forceinline__ void tile_map(int L, int nM, int nN, int& pm, int& pn) {
    const int nwg = nM * nN; int wgid = L;
    { const int q = nwg / 8, r = nwg % 8, xcd = wgid % 8, off = wgid / 8; wgid = (xcd < r ? xcd * (q + 1) : r * (q + 1) + (xcd - r) * q) + off; }
    const int nig = 8 * nN, gid = wgid / nig, fm = gid * 8, gsz = (nM - fm) < 8 ? (nM - fm) : 8;
    pm = fm + ((wgid % nig) % gsz); pn = (wgid % nig) / gsz;
}

__device__ __forceinline__ int xremap(int L, int n) { const int q = n / 8, r = n % 8, x = L % 8, off = L / 8; return (x < r ? x * (q + 1) : r * (q + 1) + (x - r) * q) + off; }

struct EU { char* o; int ldc; const float* cs; const float* rw; float* rs; float* rs2; int rstride; int rslot; int causal; float* csum; };
template <class Sched> struct EpiGen {
    static constexpr bool PERM = true;
    Sched S;
    __device__ __forceinline__ void operator()(const pg8::f32x4 (&acc)[2][2][4][2], int ui, int wr, int wc, int fr, int fq) const {
        EU e = {}; S.info(ui, e);
        asm volatile("" : "+s"(e.ldc));
        bf16* base = (bf16*)e.o;
        const int colb = wc * 32 + 8 * fq;
        f32x4 cs[2][2];
#pragma unroll
        for (int bj = 0; bj < 2; ++bj)
#pragma unroll
            for (int n = 0; n < 2; ++n) cs[bj][n] = e.cs ? *(const f32x4*)(e.cs + bj * 128 + colb + 4 * n) : (f32x4){1.f, 1.f, 1.f, 1.f};
        float rwa[2][4];
#pragma unroll
        for (int ai = 0; ai < 2; ++ai)
#pragma unroll
            for (int m = 0; m < 4; ++m) rwa[ai][m] = e.rw ? e.rw[ai * 128 + wr * 64 + m * 16 + fr] : 1.f;
#pragma unroll
        for (int ai = 0; ai < 2; ++ai)
#pragma unroll
            for (int m = 0; m < 4; ++m) {
                const int row = ai * 128 + wr * 64 + m * 16 + fr;
                const float rwv = rwa[ai][m];
                float s1 = 0.f, s2 = 0.f;
#pragma unroll
                for (int bj = 0; bj < 2; ++bj) {
                    f32x4 v0 = acc[ai][bj][m][0] * cs[bj][0] * rwv, v1 = acc[ai][bj][m][1] * cs[bj][1] * rwv;
                    if (e.causal) { const int c0 = bj * 128 + colb;
#pragma unroll
                        for (int j = 0; j < 4; ++j) { if (c0 + j > row) v0[j] = 0.f; if (c0 + 4 + j > row) v1[j] = 0.f; } }
                    s1 += (v0[0] + v0[1]) + (v0[2] + v0[3]) + (v1[0] + v1[1]) + (v1[2] + v1[3]);
                    s2 += (v0[0] * v0[0] + v0[1] * v0[1]) + (v0[2] * v0[2] + v0[3] * v0[3]) + (v1[0] * v1[0] + v1[1] * v1[1]) + (v1[2] * v1[2] + v1[3] * v1[3]);
                    v4u w; w.x = pg8::cvt_pk_bf16(v0[0], v0[1]); w.y = pg8::cvt_pk_bf16(v0[2], v0[3]); w.z = pg8::cvt_pk_bf16(v1[0], v1[1]); w.w = pg8::cvt_pk_bf16(v1[2], v1[3]);
                    *(v4u*)(base + (unsigned)(row * e.ldc + bj * 128 + colb)) = w;
                }
                if (e.rs) { s1 += __shfl_xor(s1, 16); s1 += __shfl_xor(s1, 32); if (fq == 0) e.rs[(size_t)row * e.rstride + wc * e.rslot] = s1; }
                if (e.rs2) { s2 += __shfl_xor(s2, 16); s2 += __shfl_xor(s2, 32); if (fq == 0) e.rs2[(size_t)row * e.rstride + wc * e.rslot] = s2; }
            }
        if (e.csum) {
            unsigned cbl = (unsigned)(colb * 2 + wr); asm volatile("" : "+v"(cbl));
#pragma unroll
            for (int bj = 0; bj < 2; ++bj)
#pragma unroll
                for (int n = 0; n < 2; ++n) { f32x4 c4 = (f32x4){0.f, 0.f, 0.f, 0.f};
#pragma unroll
                    for (int ai = 0; ai < 2; ++ai)
#pragma unroll
                        for (int m = 0; m < 4; ++m) c4 += acc[ai][bj][m][n];
#pragma unroll
                    for (int j = 0; j < 4; ++j) { float v = c4[j]; v += __shfl_xor(v, 1); v += __shfl_xor(v, 2); v += __shfl_xor(v, 4); v += __shfl_xor(v, 8);
                        if (fr == 0) e.csum[cbl + (unsigned)((bj * 128 + 4 * n + j) * 2)] = v; } }
        }
    }
};

__device__ __forceinline__ void transpose_item(const float* W, int ldw, bf16* WT, int ldt, int k0, int n0, int orow0, float scale, LAS float* scr, int lane) {
#pragma unroll 8
    for (int i = 0; i < 32; ++i) { const int kk = 2 * i + (lane >> 5); scr[kk * 33 + (lane & 31)] = W[(size_t)(k0 + kk) * ldw + n0 + (lane & 31)]; }
    LDS_WAIT(); asm volatile("" ::: "memory");
    const int c = lane & 7;
#pragma unroll
    for (int j = 0; j < 4; ++j) { const int n = (lane >> 3) + 8 * j; const LAS float* s = scr + (8 * c) * 33 + n;
        v4u o; o.x = pk2(s[0 * 33] * scale, s[1 * 33] * scale); o.y = pk2(s[2 * 33] * scale, s[3 * 33] * scale); o.z = pk2(s[4 * 33] * scale, s[5 * 33] * scale); o.w = pk2(s[6 * 33] * scale, s[7 * 33] * scale);
        *(GAS v4u*)(WT + (size_t)(orow0 + n) * ldt + k0 + 8 * c) = o; }
    LDS_WAIT(); asm volatile("" ::: "memory");
}
__device__ __forceinline__ void transpose_plain(const float* W, int K, int N, bf16* WT, float scale, int item, LAS float* scr, int lane) {
    const int nblk = N / 32, kb = item / nblk, nb = item % nblk;
    transpose_item(W, N, WT, K, 64 * kb, 32 * nb, 32 * nb, scale, scr, lane);
}
__device__ __forceinline__ void p0_convert(Frame& F, int lo, int hi, int p, int np) {
    if (p < 0) return;
    LAS float* scr = (LAS float*)(F.lds + RING_OFF + F.wave * 8448);
    const int gw = p * NWAVES + F.wave, NGW = np * NWAVES;
    bf16* WinT = (bf16*)(F.ws + WS_WIN); bf16* Wqkv = (bf16*)(F.ws + WS_WQKV); bf16* WoutT = (bf16*)(F.ws + WS_WOUT);
    bf16* WkvT = (bf16*)(F.ws + WS_WKV); bf16* Wq1T = (bf16*)(F.ws + WS_WQ1); bf16* Wo1T = (bf16*)(F.ws + WS_WO1);
    constexpr int I0 = 2048, I1 = 1536, I2 = 1024, I3 = 1024, I4 = 512;
    for (int it = lo + gw; it < hi; it += NGW) {
        int r = it;
        if (r < I0) { transpose_plain(KIN(F, I_AWIN), DM, 2 * DI, WinT, 1.f, r, scr, F.lane); continue; } r -= I0;
        if (r < I1) { const int mat = r / 512, hh = (r % 512) / 128, item = r % 128;
            const float* W = KIN(F, I_AWQ + mat) + (size_t)hh * DH * DH; bf16* WT = Wqkv + ((size_t)mat * NH + hh) * DH * DH;
            transpose_plain(W, DH, DH, WT, mat == 1 ? 0.044194173824159216f : 1.f, item, scr, F.lane); continue; } r -= I1;
        if (r < I2) { transpose_plain(KIN(F, I_AWOUT), DI, DM, WoutT, 1.f, r, scr, F.lane); continue; } r -= I2;
        if (r < I3) { transpose_plain(KIN(F, I_BWKV), DM, 2 * DM, WkvT, 1.f, r, scr, F.lane); continue; } r -= I3;
        if (r < I4) { transpose_plain(KIN(F, I_BWQ), DM, DM, Wq1T, 0.125f * LOG2E, r, scr, F.lane); continue; } r -= I4;
        transpose_plain(KIN(F, I_BWO), DM, DM, Wo1T, 1.f, r, scr, F.lane);
    }
}
__device__ __forceinline__ void p0_cond(Frame& F, int lo, int hi, int p, int np) {
    if (p < 0 || lo + p >= hi) return;
    LAS float* sc = (LAS float*)(F.lds + RING_OFF);
    LAS float* part = sc + 2 * DM;
    const float* c = KIN(F, I_C); const float* wa = KIN(F, I_WADA); const float* ba = KIN(F, I_BADA);
    float* cond = F.ctlf + CW_COND;
    for (int i = F.tid; i < 2 * DM; i += NTHR) sc[i] = silu_f(c[i]);
    __syncthreads();
    for (int item = lo + p; item < hi; item += np) {
        if (F.tid < 448) {
            const int g = F.tid % 14, ks = F.tid / 14; const int n = item * 56 + g * 4;
            f32x4 a0 = (f32x4){0.f, 0.f, 0.f, 0.f}, a1 = a0;
#pragma unroll 8
            for (int r = 0; r < 32; ++r) { const int kk = ks * 32 + r; const f32x4 w = *(const f32x4*)(wa + (size_t)kk * NMOD + n);
                a0 += w * sc[kk]; a1 += w * sc[DM + kk]; }
#pragma unroll
            for (int j = 0; j < 4; ++j) { part[(ks * 2 + 0) * 56 + g * 4 + j] = a0[j]; part[(ks * 2 + 1) * 56 + g * 4 + j] = a1[j]; }
        }
        __syncthreads();
        if (F.tid < 112) { const int b = F.tid / 56, col = F.tid % 56; float s = ba[item * 56 + col];
            for (int ks = 0; ks < 32; ++ks) s += part[(ks * 2 + b) * 56 + col];
            cond[b * NMOD + item * 56 + col] = s; }
        __syncthreads();
    }
}
constexpr int COND_A = 55, COND_B = 110;
__device__ __forceinline__ void p0_phase(Frame& F) {
    p0_cond(F, 0, COND_A, F.bx, F.G);
    __syncthreads();
    p0_convert(F, 0, 2048, F.bx, F.G);
    p0_convert(F, 3584, 4608, F.bx, F.G);
}
__device__ __forceinline__ void moe_weights_phase(Frame& F, int layer, size_t ws_off) {
    LAS float* scr = (LAS float*)(F.lds + RING_OFF + F.wave * 8448);
    const int gw = F.bx * NWAVES + F.wave, NGW = F.G * NWAVES;
    bf16* W1T = (bf16*)(F.ws + ws_off); bf16* W2T = W1T + (size_t)NE * 1024 * 1024;
    const float* wg = KIN(F, I_MWG) + (size_t)layer * NE * DM * DFF; const float* wu = KIN(F, I_MWU) + (size_t)layer * NE * DM * DFF; const float* wd = KIN(F, I_MWD) + (size_t)layer * NE * DFF * DM;
    for (int it = gw; it < NE * 768; it += NGW) {
        const int e = it / 768, r = it % 768;
        if (r < 512) { const int up = r >> 8, item = r & 255; const int kb = item / 16, nb = item % 16, n0 = 32 * nb;
            const float* W = (up ? wu : wg) + (size_t)e * DM * DFF;
            transpose_item(W, DFF, W1T + (size_t)e * 1024 * 1024, 1024, 64 * kb, n0, (n0 >> 7) * 256 + (n0 & 127) + up * 128, 1.f, scr, F.lane);
        } else { const int item = r - 512; const int kb = item / 32, nb = item % 32;
            transpose_item(wd + (size_t)e * DFF * DM, DM, W2T + (size_t)e * 1024 * 512, 512, 64 * kb, 32 * nb, 32 * nb, 1.f, scr, F.lane); }
    }
}

__device__ __forceinline__ void moe_weights_part(Frame& F, int layer, size_t ws_off, int p, int np, int lo = 0, int hi = NE * 768) {
    if (p < 0) return;
    LAS float* scr = (LAS float*)(F.lds + RING_OFF + F.wave * 8448);
    const int gw = p * NWAVES + F.wave, NGW = np * NWAVES;
    bf16* W1T = (bf16*)(F.ws + ws_off); bf16* W2T = W1T + (size_t)NE * 1024 * 1024;
    const float* wg = KIN(F, I_MWG) + (size_t)layer * NE * DM * DFF; const float* wu = KIN(F, I_MWU) + (size_t)layer * NE * DM * DFF; const float* wd = KIN(F, I_MWD) + (size_t)layer * NE * DFF * DM;
    for (int it = lo + gw; it < hi; it += NGW) {
        const int e = it / 768, r = it % 768;
        if (r < 512) { const int up = r >> 8, item = r & 255; const int kb = item / 16, nb = item % 16, n0 = 32 * nb;
            const float* W = (up ? wu : wg) + (size_t)e * DM * DFF;
            transpose_item(W, DFF, W1T + (size_t)e * 1024 * 1024, 1024, 64 * kb, n0, (n0 >> 7) * 256 + (n0 & 127) + up * 128, 1.f, scr, F.lane);
        } else { const int item = r - 512; const int kb = item / 32, nb = item % 32;
            transpose_item(wd + (size_t)e * DFF * DM, DM, W2T + (size_t)e * 1024 * 512, 512, 64 * kb, 32 * nb, 32 * nb, 1.f, scr, F.lane); }
    }
}

__device__ __forceinline__ void p1_phase(Frame& F) {
    const float* x = KIN(F, I_X); const float* cond = F.ctlf + CW_COND; bf16* H0 = (bf16*)(F.ws + WS_H0);
    const int gw = F.bx * NWAVES + F.wave, NGW = F.G * NWAVES;
    for (int mp = gw; mp < M / 2; mp += NGW) {
        const int m0 = mp * 2, b = m0 / SEQ; const float* cb = cond + b * NMOD;
        f32x4 v[2][4];
#pragma unroll
        for (int q = 0; q < 2; ++q)
#pragma unroll
            for (int j = 0; j < 4; ++j) v[q][j] = *((const GAS f32x4*)(x + (size_t)(m0 + q) * DM) + F.lane + 64 * j);
#pragma unroll
        for (int q = 0; q < 2; ++q) { GAS v2u* o8 = (GAS v2u*)(H0 + (size_t)(m0 + q) * DM) + F.lane;
#pragma unroll
            for (int j = 0; j < 4; ++j) { const int col = 4 * F.lane + 256 * j;
                const f32x4 sh = *(const f32x4*)(cb + mod_off(0, 0, 0) + col), sc = *(const f32x4*)(cb + mod_off(0, 0, 1) + col);
                const f32x4 h = v[q][j] * (sc + 1.f) + sh; v2u w; w.x = pk2(h[0], h[1]); w.y = pk2(h[2], h[3]); o8[64 * j] = w; } }
    }
}

__device__ __forceinline__ float logsigmoid_f(float v) { return fminf(v, 0.f) - log1pf(__expf(-fabsf(v))); }
__device__ __forceinline__ void p3_phase(Frame& F) {
    const bf16* XM = (const bf16*)(F.ws + WS_XM); bf16* XC = (bf16*)(F.ws + WS_XC); float* Gt = F.smallf + SW_G;
    const float* cw = KIN(F, I_ACONVW); const float* cb = KIN(F, I_ACONVB); const float* wif = KIN(F, I_AWIF); const float* bif = KIN(F, I_ABIF);
    LAS float* scr = (LAS float*)(F.lds + RING_OFF + F.wave * 16384);
    const int gw = F.bx * NWAVES + F.wave, NGW = F.G * NWAVES, lane = F.lane;
    for (int run = gw; run < M / 8; run += NGW) {
        const int t0 = run * 8, tl0 = t0 % SEQ;
        float gacc[8][8];
#pragma unroll
        for (int a = 0; a < 8; ++a)
#pragma unroll
            for (int g = 0; g < 8; ++g) gacc[a][g] = 0.f;
#pragma unroll 1
        for (int j = 0; j < 8; ++j) {
            const int ch0 = j * 256 + lane * 4;
            f32x4 w0 = *(const f32x4*)(cw + 0 * DI + ch0), w1 = *(const f32x4*)(cw + 1 * DI + ch0), w2 = *(const f32x4*)(cw + 2 * DI + ch0), w3 = *(const f32x4*)(cw + 3 * DI + ch0);
            const f32x4 bb = *(const f32x4*)(cb + ch0);
            f32x4 wf[4][2];
#pragma unroll
            for (int c = 0; c < 4; ++c) { wf[c][0] = *(const f32x4*)(wif + (size_t)(ch0 + c) * 8); wf[c][1] = *(const f32x4*)(wif + (size_t)(ch0 + c) * 8 + 4); }
            f32x4 xa, xb, xc_;
            {
                v2u r; const f32x4 z = (f32x4){0.f, 0.f, 0.f, 0.f};
                if (tl0 >= 3) { r = *(const v2u*)(XM + (size_t)(t0 - 3) * DI + ch0); xa = (f32x4){bflo(r.x), bfhi(r.x), bflo(r.y), bfhi(r.y)}; } else xa = z;
                if (tl0 >= 2) { r = *(const v2u*)(XM + (size_t)(t0 - 2) * DI + ch0); xb = (f32x4){bflo(r.x), bfhi(r.x), bflo(r.y), bfhi(r.y)}; } else xb = z;
                if (tl0 >= 1) { r = *(const v2u*)(XM + (size_t)(t0 - 1) * DI + ch0); xc_ = (f32x4){bflo(r.x), bfhi(r.x), bflo(r.y), bfhi(r.y)}; } else xc_ = z;
            }
#pragma unroll
            for (int tt = 0; tt < 8; ++tt) {
                const v2u r = *(const v2u*)(XM + (size_t)(t0 + tt) * DI + ch0);
                const f32x4 xd = (f32x4){bflo(r.x), bfhi(r.x), bflo(r.y), bfhi(r.y)};
                f32x4 y = bb + w0 * xa + w1 * xb + w2 * xc_ + w3 * xd;
                f32x4 s; s[0] = silu_f(y[0]); s[1] = silu_f(y[1]); s[2] = silu_f(y[2]); s[3] = silu_f(y[3]);
                v2u o; o.x = pk2(s[0], s[1]); o.y = pk2(s[2], s[3]);
                *(v2u*)(XC + (size_t)(t0 + tt) * DI + ch0) = o;
#pragma unroll
                for (int c = 0; c < 4; ++c) {
#pragma unroll
                    for (int g = 0; g < 4; ++g) { gacc[tt][g] += s[c] * wf[c][0][g]; gacc[tt][4 + g] += s[c] * wf[c][1][g]; }
                }
                xa = xb; xb = xc_; xc_ = xd;
            }
        }
#pragma unroll
        for (int tt = 0; tt < 8; ++tt)
#pragma unroll
            for (int g = 0; g < 8; ++g) { const int v = tt * 8 + g; scr[v * 64 + (lane ^ v)] = gacc[tt][g]; }
        LDS_WAIT(); asm volatile("" ::: "memory");
        float tot = 0.f;
#pragma unroll 16
        for (int l = 0; l < 64; ++l) tot += scr[lane * 64 + (l ^ lane)];
        LDS_WAIT(); asm volatile("" ::: "memory");
        const int tt = lane >> 3, g = lane & 7;
        float v = tot + bif[g];
        if (g >= 4) v = logsigmoid_f(v);
        Gt[(size_t)(t0 + tt) * 8 + g] = v;
    }
}

__device__ __forceinline__ void p3b_phase(Frame& F) {
    const float* Gt = F.smallf + SW_G;
    LAS float* lbl = (LAS float*)(F.lds + RING_OFF);
    for (int item = F.bx; item < 8; item += F.G) {
        const int b = item >> 2, h = item & 3, tid = F.tid, lane = F.lane;
        const int tb = tid * 16;
        float fi[16], bb[16];
        float run = 0.f;
#pragma unroll
        for (int s = 0; s < 16; ++s) { const size_t gi = ((size_t)(b * SEQ + tb + s)) * 8; fi[s] = Gt[gi + h]; run += Gt[gi + 4 + h]; bb[s] = run; }
        const float total = run;
        float incl = total;
#pragma unroll
        for (int o = 1; o < 16; o <<= 1) { const float v = __shfl_up(incl, o, 16); if ((lane & 15) >= o) incl += v; }
        const float excl = incl - total;
        const float blast = __shfl(incl, (lane & ~15) + 15);
        float gl = -INFINITY;
#pragma unroll
        for (int s = 0; s < 16; ++s) { bb[s] += excl; gl = fmaxf(gl, blast - bb[s] + fi[s]); }
#pragma unroll
        for (int o = 1; o < 16; o <<= 1) gl = fmaxf(gl, __shfl_xor(gl, o));
        const int c = tid >> 4;
        __syncthreads();
        if ((lane & 15) == 0) { lbl[c] = blast; lbl[32 + c] = gl; }
        __syncthreads();
        if (tid == 0) { float m = 0.f; for (int cc = 0; cc < NCH; ++cc) { lbl[64 + cc] = m; m = fmaxf(lbl[cc] + m, lbl[32 + cc]); lbl[96 + cc] = m; } }
        __syncthreads();
        const float mprev = lbl[64 + c], mnew = lbl[96 + c];
        float* WK = F.smallf + SW_WK + (size_t)item * SEQ + tb; float* CS = F.smallf + SW_CS + (size_t)item * SEQ + tb; float* EA = F.smallf + SW_EA + (size_t)item * SEQ + tb;
#pragma unroll
        for (int s = 0; s < 16; ++s) { WK[s] = __expf(blast - bb[s] + fi[s] - mnew); CS[s] = __expf(fi[s] - bb[s] - mprev); EA[s] = __expf(-(bb[s] + mprev)); }
        if ((lane & 15) == 0) F.smallf[SW_DEC + item * NCH + c] = __expf(blast + mprev - mnew);
        __syncthreads();
    }
}
struct SchedPlain {
    const char* A; const char* B; char* O; int lda, ldb, ldc, nM, nN, G, c;
    __device__ __forceinline__ bool next(int i, const char*& a, const char*& b) const {
        const int L = i * G + c; if (L >= nM * nN) return false; int pm, pn; tile_map(L, nM, nN, pm, pn);
        a = A + (size_t)pm * 256 * lda * 2; b = B + (size_t)pn * 256 * ldb * 2; return true; }
    __device__ __forceinline__ void tile(int i, int& pm, int& pn) const { tile_map(i * G + c, nM, nN, pm, pn); }
    __device__ __forceinline__ void info(int i, EU& e) const { int pm, pn; tile(i, pm, pn);
        e.o = O + ((size_t)pm * 256 * ldc + pn * 256) * 2; e.ldc = ldc; e.cs = nullptr; e.rw = nullptr; e.rs = nullptr; e.rs2 = nullptr; e.rstride = 0; e.rslot = 0; e.causal = 0; }
};
struct SchedQK {
    const char* XC; const char* Wq; const char* Wk; char* AQ; char* KB; int bsel, G, c;
    __device__ __forceinline__ void decode(int i, int& ty, int& z, int& pn) const { const int u = xremap(i * G + c, 512); ty = ((u >> 1) ^ (u >> 5)) & 1; z = u >> 2; pn = u & 1; }
    __device__ __forceinline__ bool next(int i, const char*& a, const char*& b) const {
        if (i * G + c >= 512) return false; int ty, z, pn; decode(i, ty, z, pn); const int h = z >> 5, ch = z & 31;
        a = XC + ((size_t)(bsel * SEQ + ch * 256) * DI + h * DH) * 2; b = (ty ? Wk : Wq) + ((size_t)(h * DH + pn * 256) * DH) * 2; return true; }
};
struct EpiQK {
    static constexpr bool PERM = true;
    SchedQK S; char* KWT; const float* WK; float* DN;
    __device__ __forceinline__ void operator()(const pg8::f32x4 (&acc)[2][2][4][2], int ui, int wr, int wc, int fr, int fq) const {
        int ty, z, pn; S.decode(ui, ty, z, pn); const int h = z >> 5, ch = z & 31;
        bf16* base; int ldc;
        if (ty == 0) { base = (bf16*)(S.AQ + ((size_t)z * 256 * 768 + 256 + pn * 256) * 2); ldc = 768; } else { base = (bf16*)(S.KB + ((size_t)(ch * 256) * DI + h * DH + pn * 256) * 2); ldc = DI; }
        asm volatile("" : "+s"(ldc));
        const int colb = wc * 32 + 8 * fq;
        float wt[2][4];
        { const float* wk = WK + (size_t)(S.bsel * NH + h) * SEQ + ch * 256;
#pragma unroll
          for (int ai = 0; ai < 2; ++ai)
#pragma unroll
            for (int m = 0; m < 4; ++m) wt[ai][m] = ty ? wk[ai * 128 + wr * 64 + m * 16 + fr] : 1.f; }
#pragma unroll
        for (int ai = 0; ai < 2; ++ai)
#pragma unroll
            for (int m = 0; m < 4; ++m) {
                const int row = ai * 128 + wr * 64 + m * 16 + fr;
#pragma unroll
                for (int bj = 0; bj < 2; ++bj) { const f32x4 v0 = acc[ai][bj][m][0], v1 = acc[ai][bj][m][1];
                    v4u w; w.x = pg8::cvt_pk_bf16(v0[0], v0[1]); w.y = pg8::cvt_pk_bf16(v0[2], v0[3]); w.z = pg8::cvt_pk_bf16(v1[0], v1[1]); w.w = pg8::cvt_pk_bf16(v1[2], v1[3]);
                    *(v4u*)(base + (unsigned)(row * ldc + bj * 128 + colb)) = w; }
            }
        if (ty) {
            bf16* kt = (bf16*)(KWT + ((size_t)(z * 512 + pn * 256) * 256) * 2);
            const unsigned one = (fr & 1) ? 0x3F800000u : 0x00003F80u; const int wsel = (fr & 7) >> 1;
            const bool on0 = (fq == (fr >> 3)), on1 = (fq == 2 + (fr >> 3));
            pg8::u32x4 s0, s1;
#pragma unroll
            for (int i = 0; i < 4; ++i) { s0[i] = (on0 && wsel == i) ? one : 0u; s1[i] = (on1 && wsel == i) ? one : 0u; }
            const pg8::bf16x8 sel0 = __builtin_bit_cast(pg8::bf16x8, s0), sel1 = __builtin_bit_cast(pg8::bf16x8, s1);
            float cs[2][2] = {{0.f, 0.f}, {0.f, 0.f}};
            unsigned fb = (unsigned)((wc * 32 + fr) * 256 + wr * 64 + 4 * fq); asm volatile("" : "+v"(fb));
#pragma unroll
            for (int ai = 0; ai < 2; ++ai)
#pragma unroll
                for (int m = 0; m < 4; ++m) {
#pragma unroll
                    for (int bj = 0; bj < 2; ++bj) { const f32x4 v0 = acc[ai][bj][m][0] * wt[ai][m], v1 = acc[ai][bj][m][1] * wt[ai][m];
                        pg8::u32x4 pa; pa[0] = pg8::cvt_pk_bf16(v0[0], v0[1]); pa[1] = pg8::cvt_pk_bf16(v0[2], v0[3]); pa[2] = pg8::cvt_pk_bf16(v1[0], v1[1]); pa[3] = pg8::cvt_pk_bf16(v1[2], v1[3]);
                        const pg8::bf16x8 a = __builtin_bit_cast(pg8::bf16x8, pa);
                        const f32x4 d0 = __builtin_amdgcn_mfma_f32_16x16x32_bf16(a, sel0, (f32x4){0.f, 0.f, 0.f, 0.f}, 0, 0, 0), d1 = __builtin_amdgcn_mfma_f32_16x16x32_bf16(a, sel1, (f32x4){0.f, 0.f, 0.f, 0.f}, 0, 0, 0);
                        const unsigned o = fb + (unsigned)(bj * 128 * 256 + ai * 128 + m * 16);
                        v2u w0, w1; w0.x = pg8::cvt_pk_bf16(d0[0], d0[1]); w0.y = pg8::cvt_pk_bf16(d0[2], d0[3]); w1.x = pg8::cvt_pk_bf16(d1[0], d1[1]); w1.y = pg8::cvt_pk_bf16(d1[2], d1[3]);
                        *(v2u*)(kt + o) = w0; *(v2u*)(kt + o + 16 * 256) = w1;
                        cs[bj][0] += (d0[0] + d0[1]) + (d0[2] + d0[3]); cs[bj][1] += (d1[0] + d1[1]) + (d1[2] + d1[3]); }
                }
            float* dn = DN + (((size_t)((S.bsel * NH + h) * NCH + ch)) * DH + pn * 256) * 2 + wr;
#pragma unroll
            for (int bj = 0; bj < 2; ++bj)
#pragma unroll
                for (int j = 0; j < 2; ++j) { float v = cs[bj][j]; v += __shfl_xor(v, 16); v += __shfl_xor(v, 32);
                    if (fq == 0) dn[(bj * 128 + wc * 32 + j * 16 + fr) * 2] = v; }
        }
    }
};
struct SchedKV {
    const char* XM; const char* Wv; char* BC; int bsel, G, c;
    __device__ __forceinline__ bool next(int i, const char*& a, const char*& b) const {
        if (i * G + c >= 256) return false; const int L = xremap(i * G + c, 256); const int z = L >> 1, pm = L & 1, h = z >> 5, ch = z & 31;
        a = Wv + ((size_t)(h * DH + pm * 256) * DH) * 2; b = XM + ((size_t)(bsel * SEQ + ch * 256) * DI + h * DH) * 2; return true; }
    __device__ __forceinline__ void info(int i, EU& e) const {
        const int L = xremap(i * G + c, 256); const int z = L >> 1, pm = L & 1;
        e.rw = nullptr; e.rs2 = nullptr; e.causal = 0; e.rslot = 0;
        e.o = BC + ((size_t)(z * 512 + pm * 256) * 768) * 2; e.ldc = 768; e.cs = nullptr; e.rs = nullptr; e.rstride = 0; }
};
struct SchedS {
    char* AQ; const char* KB; const float* CS; float* DENI; int bsel, G, c;
    __device__ __forceinline__ int zof(int i) const { if (G == 256) { const int x = c & 7, j = c >> 3; return (i == 0 && j < 16) ? 16 * x + j : -1; } const int L = i * G + c; return L < 128 ? L : -1; }
    __device__ __forceinline__ bool next(int i, const char*& a, const char*& b) const {
        const int z = zof(i); if (z < 0) return false; const int h = z >> 5, ch = z & 31;
        a = AQ + ((size_t)z * 256 * 768 + 256) * 2; b = KB + ((size_t)(ch * 256) * DI + h * DH) * 2; return true; }
    __device__ __forceinline__ void info(int i, EU& e) const {
        const int z = zof(i), h = z >> 5, ch = z & 31;
        e.o = AQ + ((size_t)z * 256 * 768) * 2; e.ldc = 768; e.cs = CS + (size_t)(bsel * NH + h) * SEQ + ch * 256; e.rw = nullptr;
        e.rs = DENI + ((size_t)(bsel * NH + h) * SEQ + ch * 256) * 4; e.rs2 = nullptr; e.rstride = 4; e.rslot = 1; e.causal = 1; }
};
struct SchedDC {
    char* BC; const char* KWT; int G, c;
    __device__ __forceinline__ int lin(int i) const {
        if (G == 256) { const int x = c & 7, j = c >> 3;
            if (j < 16) return i == 0 ? 4 * (16 * x + 12 + (j >> 2)) + (j & 3) : -1;
            return i < 3 ? 4 * (16 * x + i * 4 + ((j - 16) >> 2)) + ((j - 16) & 3) : -1; }
        const int L = i * G + c; return L < 512 ? L : -1; }
    __device__ __forceinline__ bool next(int i, const char*& a, const char*& b) const {
        const int L = lin(i); if (L < 0) return false; const int z = L >> 2, pm = (L >> 1) & 1, pn = L & 1;
        a = BC + ((size_t)(z * 512 + pm * 256) * 768) * 2; b = KWT + ((size_t)(z * 512 + pn * 256) * 256) * 2; return true; }
    __device__ __forceinline__ void info(int i, EU& e) const {
        const int L = lin(i); const int z = L >> 2, pm = (L >> 1) & 1, pn = L & 1;
        e.o = BC + ((size_t)(z * 512 + pm * 256) * 768 + 256 + pn * 256) * 2; e.ldc = 768; e.cs = nullptr; e.rw = nullptr; e.rs = nullptr; e.rs2 = nullptr; e.rstride = 0; e.rslot = 0; e.causal = 0; }
};
struct SchedH {
    const char* AQ; const char* BC; char* HB; const float* DENF; float* HSTAT; int bsel, G, c;
    __device__ __forceinline__ bool next(int i, const char*& a, const char*& b) const {
        if (i * G + c >= 256) return false; const int L = xremap(i * G + c, 256); const int z = L >> 1, pn = L & 1;
        a = AQ + ((size_t)z * 256 * 768) * 2; b = BC + ((size_t)(z * 512 + pn * 256) * 768) * 2; return true; }
    __device__ __forceinline__ void info(int i, EU& e) const {
        const int L = xremap(i * G + c, 256); const int z = L >> 1, pn = L & 1, h = z >> 5, ch = z & 31;
        const size_t row0 = (size_t)bsel * SEQ + ch * 256;
        e.o = HB + (row0 * DI + h * DH + pn * 256) * 2; e.ldc = DI; e.cs = nullptr; e.rw = DENF + (size_t)(bsel * NH + h) * SEQ + ch * 256;
        e.rs = HSTAT + (row0 * NH + h) * 16 + pn * 8; e.rs2 = e.rs + 1; e.rstride = NH * 16; e.rslot = 2; e.causal = 0; }
};

__device__ __forceinline__ void p6_phase(Frame& F, int bsel) {
    bf16* BC = (bf16*)(F.ws + WS_BC); const float* DEC = F.smallf + SW_DEC;
    {
        const int gt = F.bx * NTHR + F.tid, NGT = F.G * NTHR;
        for (int e = gt; e < NH * DH * (DH / 8); e += NGT) {
            const int h = e / (DH * 64), v = (e / 64) % DH, kv = e % 64;
            const float* dec = DEC + (bsel * NH + h) * NCH;
            bf16* p = BC + ((size_t)(h * NCH) * 512 + v) * 768 + 256 + kv * 8;
            float carry[8];
#pragma unroll
            for (int j = 0; j < 8; ++j) carry[j] = 0.f;
            v4u dv[NCH];
#pragma unroll
            for (int c = 0; c < NCH; ++c) dv[c] = *(const v4u*)(p + (size_t)c * 512 * 768);
#pragma unroll
            for (int c = 0; c < NCH; ++c) {
                v4u* q = (v4u*)(p + (size_t)c * 512 * 768);
                const v4u d = dv[c]; const float dc = dec[c];
                v4u o; o.x = pk2(carry[0], carry[1]); o.y = pk2(carry[2], carry[3]); o.z = pk2(carry[4], carry[5]); o.w = pk2(carry[6], carry[7]);
                *q = o;
                carry[0] = carry[0] * dc + bflo(d.x); carry[1] = carry[1] * dc + bfhi(d.x); carry[2] = carry[2] * dc + bflo(d.y); carry[3] = carry[3] * dc + bfhi(d.y);
                carry[4] = carry[4] * dc + bflo(d.z); carry[5] = carry[5] * dc + bfhi(d.z); carry[6] = carry[6] * dc + bflo(d.w); carry[7] = carry[7] * dc + bfhi(d.w);
            }
        }
    }
    {
        LAS float* nv = (LAS float*)(F.lds + RING_OFF);
        const bf16* AQ = (const bf16*)(F.ws + WS_AQ);
        const float* DN = F.ctlf + CW_DN; const float* DENI = F.ctlf + CW_DENI; const float* EA = F.smallf + SW_EA; float* DENF = F.smallf + SW_DENF;
        for (int u = F.bx; u < NH * NCH * 2; u += F.G) {
            const int z = u >> 1, half = u & 1, h = z >> 5, ch = z & 31, bh = bsel * NH + h;
            __syncthreads();
            { const int k = F.tid; float n = 0.f; const float* dec = DEC + bh * NCH; const float* dn = DN + ((size_t)bh * NCH * DH + k) * 2;
#pragma unroll 8
              for (int c = 0; c < ch; ++c) { const pg8::f32x2 d2 = *(const pg8::f32x2*)(dn + (size_t)c * DH * 2); n = n * dec[c] + (d2[0] + d2[1]); }
              nv[k] = n; }
            __syncthreads();
            const int t = half * 128 + (F.tid >> 2), qd = F.tid & 3;
            const v4u* qp = (const v4u*)(AQ + ((size_t)z * 256 + t) * 768 + 256 + qd * 128);
            v4u qv[16];
#pragma unroll
            for (int i = 0; i < 16; ++i) qv[i] = qp[i];
            float s = 0.f;
#pragma unroll
            for (int i = 0; i < 16; ++i) { const LAS f32x4* np = (const LAS f32x4*)(nv + qd * 128 + i * 8); const f32x4 n0 = np[0], n1 = np[1];
                s += bflo(qv[i].x) * n0[0] + bfhi(qv[i].x) * n0[1] + bflo(qv[i].y) * n0[2] + bfhi(qv[i].y) * n0[3] + bflo(qv[i].z) * n1[0] + bfhi(qv[i].z) * n1[1] + bflo(qv[i].w) * n1[2] + bfhi(qv[i].w) * n1[3]; }
            s += __shfl_xor(s, 1); s += __shfl_xor(s, 2);
            if (qd == 0) { const size_t ti = (size_t)bh * SEQ + ch * 256 + t; const f32x4 d4 = *(const f32x4*)(DENI + ti * 4); const float den = ((d4[0] + d4[1]) + (d4[2] + d4[3])) + s; DENF[ti] = 1.f / fmaxf(fabsf(den), EA[ti]); }
        }
    }
}

struct EpiZ {
    static constexpr bool PERM = true;
    SchedPlain S; const bf16* HB; const bf16* XC; const float* HSTAT; const float* gn; const float* skip;
    __device__ __forceinline__ void operator()(const pg8::f32x4 (&acc)[2][2][4][2], int ui, int wr, int wc, int fr, int fq) const {
        int pm, pn; S.tile(ui, pm, pn);
        bf16* O = (bf16*)S.O; const int head = pn >> 1;
        const int colb = pn * 256 + wc * 32 + 8 * fq;
        f32x4 g4[2][2], s4[2][2];
#pragma unroll
        for (int bj = 0; bj < 2; ++bj)
#pragma unroll
            for (int n = 0; n < 2; ++n) { g4[bj][n] = *(const f32x4*)(gn + colb + bj * 128 + 4 * n); s4[bj][n] = *(const f32x4*)(skip + colb + bj * 128 + 4 * n); }
#pragma unroll
        for (int ai = 0; ai < 2; ++ai)
#pragma unroll
            for (int m = 0; m < 4; ++m) {
                const size_t row = (size_t)pm * 256 + ai * 128 + wr * 64 + m * 16 + fr;
                const f32x4* sp = (const f32x4*)(HSTAT + (row * NH + head) * 16); const f32x4 q0 = sp[0], q1 = sp[1], q2 = sp[2], q3 = sp[3];
                const float ssum = ((q0[0] + q0[2]) + (q1[0] + q1[2])) + ((q2[0] + q2[2]) + (q3[0] + q3[2])), ssq = ((q0[1] + q0[3]) + (q1[1] + q1[3])) + ((q2[1] + q2[3]) + (q3[1] + q3[3]));
                const float mu = ssum * (1.f / DH); const float var = fmaxf(ssq * (1.f / DH) - mu * mu, 0.f); const float rstd = rsqrtf(var + LN_EPS);
#pragma unroll
                for (int bj = 0; bj < 2; ++bj) {
                    const size_t off = row * DI + colb + bj * 128;
                    const v4u hb = *(const v4u*)(HB + off), xb = *(const v4u*)(XC + off);
                    const float hv[8] = {bflo(hb.x), bfhi(hb.x), bflo(hb.y), bfhi(hb.y), bflo(hb.z), bfhi(hb.z), bflo(hb.w), bfhi(hb.w)};
                    const float xv[8] = {bflo(xb.x), bfhi(xb.x), bflo(xb.y), bfhi(xb.y), bflo(xb.z), bfhi(xb.z), bflo(xb.w), bfhi(xb.w)};
                    float r[8];
#pragma unroll
                    for (int j = 0; j < 8; ++j) { const float zz = acc[ai][bj][m][j >> 2][j & 3]; const float hn = (hv[j] - mu) * rstd;
                        r[j] = (hn * g4[bj][j >> 2][j & 3] + s4[bj][j >> 2][j & 3] * xv[j]) * silu_f(zz); }
                    v4u w; w.x = pg8::cvt_pk_bf16(r[0], r[1]); w.y = pg8::cvt_pk_bf16(r[2], r[3]); w.z = pg8::cvt_pk_bf16(r[4], r[5]); w.w = pg8::cvt_pk_bf16(r[6], r[7]);
                    *(v4u*)(O + off) = w;
                }
            }
    }
};

struct EpiRes {
    static constexpr bool PERM = true;
    SchedPlain S; const float* X; float* U; const float* cond; int goff;
    __device__ __forceinline__ void operator()(const pg8::f32x4 (&acc)[2][2][4][2], int ui, int wr, int wc, int fr, int fq) const {
        int pm, pn; S.tile(ui, pm, pn);
        const int b = (pm * 256) / SEQ; const int colb = pn * 256 + wc * 32 + 8 * fq;
        f32x4 g4[2][2];
#pragma unroll
        for (int bj = 0; bj < 2; ++bj)
#pragma unroll
            for (int n = 0; n < 2; ++n) g4[bj][n] = *(const f32x4*)(cond + b * NMOD + goff + colb + bj * 128 + 4 * n) + 1.f;
#pragma unroll
        for (int ai = 0; ai < 2; ++ai)
#pragma unroll
            for (int m = 0; m < 4; ++m) {
                const size_t row = (size_t)pm * 256 + ai * 128 + wr * 64 + m * 16 + fr;
#pragma unroll
                for (int bj = 0; bj < 2; ++bj)
#pragma unroll
                    for (int n = 0; n < 2; ++n) { const size_t off = row * DM + colb + bj * 128 + 4 * n;
                        const f32x4 xv = *(const f32x4*)(X + off); *(f32x4*)(U + off) = xv * DN_ALPHA + g4[bj][n] * acc[ai][bj][m][n]; }
            }
    }
};
__device__ __forceinline__ void ln_row(f32x4 (&v)[4], const float* g, const float* b, int lane) {
    float s = 0.f;
#pragma unroll
    for (int j = 0; j < 4; ++j) s += (v[j][0] + v[j][1]) + (v[j][2] + v[j][3]);
    const float mean = wave_sum_dpp(s) * (1.f / DM); float s2 = 0.f;
#pragma unroll
    for (int j = 0; j < 4; ++j) { v[j] = v[j] - mean; s2 += (v[j][0] * v[j][0] + v[j][1] * v[j][1]) + (v[j][2] * v[j][2] + v[j][3] * v[j][3]); }
    const float rstd = rsqrtf(wave_sum_dpp(s2) * (1.f / DM) + LN_EPS);
#pragma unroll
    for (int j = 0; j < 4; ++j) { const int col = 4 * lane + 256 * j; v[j] = v[j] * rstd * *(const f32x4*)(g + col) + *(const f32x4*)(b + col); }
}

__device__ __forceinline__ void fin_test_phase(Frame& F, const float* U, int nskip_from) {
    const float* lng = KIN(F, I_LNG); const float* lnb = KIN(F, I_LNB);
    const int gw = F.bx * NWAVES + F.wave, NGW = F.G * NWAVES;
    for (int m = gw; m < M; m += NGW) {
        f32x4 v[4];
#pragma unroll
        for (int j = 0; j < 4; ++j) v[j] = *((const GAS f32x4*)(U + (size_t)m * DM) + F.lane + 64 * j);
        for (int s = nskip_from; s < 4; ++s) {
#pragma unroll
            for (int j = 0; j < 4; ++j) v[j] = v[j] * DN_ALPHA;
            ln_row(v, lng + s * DM, lnb + s * DM, F.lane);
        }
        if (m == 0 && F.lane == 0) { const unsigned d = F.ctl[CW_DBG]; if (d) v[0][0] = 4096.f * exp2f((float)d * 0.830482f); }
#pragma unroll
        for (int j = 0; j < 4; ++j) *((GAS f32x4*)(F.out + (size_t)m * DM) + F.lane + 64 * j) = v[j];
    }
}

constexpr int LDS_TAB_OFF = LDSCTL_OFF + 1024;

__device__ __forceinline__ void moe_route_phase(Frame& F, const float* X, const bf16* XH, int xh_off, const bf16* Y, bf16* HM, int layer, int lnidx, int cslot, int rflags = 0) {
    LAS float* wrT = (LAS float*)(F.lds + RING_OFF);
    { const float* wr = KIN(F, I_MWR); for (int i = F.tid; i < DM * NE; i += NTHR) wrT[(i & 15) * DM + (i >> 4)] = wr[i]; }
    const float* br = KIN(F, I_MBR);
    const float* cond = F.ctlf + CW_COND;
    int* IDX = (int*)(F.smallf + SW_IDX); float* WTS = F.smallf + SW_WTS; int* POS = (int*)(F.smallf + SW_POS);
    int* cnt = (int*)(F.ctl + CW_MOECNT + cslot * 1024);
    LAS int* lcnt = (LAS int*)(F.lds + RING_OFF + 65536);
    LAS float* prm = (LAS float*)(F.lds + RING_OFF + 74240);
    {
        const float* lng = KIN(F, I_LNG) + lnidx * DM; const float* lnb = KIN(F, I_LNB) + lnidx * DM;
        for (int i = F.tid; i < 2 * DM; i += NTHR) { const int b = i >> 10, col = i & 1023; const float* cb = cond + b * NMOD; LAS float* pb = prm + b * 5 * DM + col;
            const float sc1 = cb[mod_off(layer, 1, 1) + col] + 1.f;
            pb[0] = cb[mod_off(layer, 0, 2) + col] + 1.f; pb[DM] = lng[col] * sc1; pb[2 * DM] = lnb[col] * sc1 + cb[mod_off(layer, 1, 0) + col];
            if (!X) { pb[3 * DM] = cb[xh_off + col]; pb[4 * DM] = 1.f / (cb[xh_off + DM + col] + 1.f); } }
    }
    if (F.tid < 32) lcnt[F.tid] = 0;
    __syncthreads();
    const int gw = F.bx * NWAVES + F.wave, NGW = F.G * NWAVES, lane = F.lane;
    const bool b5 = (lane & 32) != 0, b4 = (lane & 16) != 0, b3 = (lane & 8) != 0, b2 = (lane & 4) != 0;
    LAS float* lgbuf = (LAS float*)(lcnt + 64) + F.wave * 256;
    f32x4 cx[2][4], nx[2][4]; v2u ch[2][4], nh[2][4], cy[2][4], ny[2][4];
#define ROUTE_LOAD(mp_, xx, hh, yy) do { _Pragma("unroll") for (int q_ = 0; q_ < 2; ++q_) _Pragma("unroll") for (int j_ = 0; j_ < 4; ++j_) { const size_t ro_ = (size_t)((mp_) * 2 + q_) * DM; \
        if (X) xx[q_][j_] = *((const GAS f32x4*)(X + ro_) + lane + 64 * j_); else hh[q_][j_] = *((const GAS v2u*)(XH + ro_) + lane + 64 * j_); \
        yy[q_][j_] = *((const GAS v2u*)(Y + ro_) + lane + 64 * j_); } } while (0)
    if (gw < M / 2) ROUTE_LOAD(gw, cx, ch, cy);
    int it = 0;
    for (int mp = gw; mp < M / 2; mp += NGW, ++it) {
        const int m0 = mp * 2; const int b = m0 / SEQ;
        if (mp + NGW < M / 2) ROUTE_LOAD(mp + NGW, nx, nh, ny);
        unsigned wofs = 0; asm volatile("" : "+v"(wofs));
        LAS const float* wrL = wrT + wofs; LAS const float* pb = prm + wofs + b * 5 * DM;
        f32x4 vv[2][4];
#pragma unroll
        for (int q = 0; q < 2; ++q)
#pragma unroll
            for (int j = 0; j < 4; ++j) { f32x4 xv; const int col = 4 * lane + 256 * j;
                if (X) xv = cx[q][j];
                else { const v2u hw = ch[q][j]; const f32x4 hv = (f32x4){bflo(hw.x), bfhi(hw.x), bflo(hw.y), bfhi(hw.y)};
                    xv = (hv - *(const LAS f32x4*)(pb + 3 * DM + col)) * *(const LAS f32x4*)(pb + 4 * DM + col); }
                const v2u yw = cy[q][j];
                vv[q][j] = xv * DN_ALPHA + *(const LAS f32x4*)(pb + col) * (f32x4){bflo(yw.x), bfhi(yw.x), bflo(yw.y), bfhi(yw.y)}; }
#pragma unroll
        for (int q = 0; q < 2; ++q) {
            const int m = m0 + q;
            if (!(rflags & 2)) {
                float s1 = 0.f;
#pragma unroll
                for (int j = 0; j < 4; ++j) s1 += (vv[q][j][0] + vv[q][j][1]) + (vv[q][j][2] + vv[q][j][3]);
                const float mean = wave_sum_dpp(s1) * (1.f / DM); float s2 = 0.f;
#pragma unroll
                for (int j = 0; j < 4; ++j) { vv[q][j] = vv[q][j] - mean; s2 += (vv[q][j][0] * vv[q][j][0] + vv[q][j][1] * vv[q][j][1]) + (vv[q][j][2] * vv[q][j][2] + vv[q][j][3] * vv[q][j][3]); }
                const float rstd = rsqrtf(wave_sum_dpp(s2) * (1.f / DM) + LN_EPS);
#pragma unroll
                for (int j = 0; j < 4; ++j) vv[q][j] = vv[q][j] * rstd;
            }
            float lg[16];
#pragma unroll
            for (int e = 0; e < 16; ++e) lg[e] = 0.f;
#pragma unroll
            for (int j = 0; j < 4; ++j) { const int col = 4 * lane + 256 * j;
                const f32x4 h = vv[q][j] * *(const LAS f32x4*)(pb + DM + col) + *(const LAS f32x4*)(pb + 2 * DM + col);
                v2u w; w.x = pk2(h[0], h[1]); w.y = pk2(h[2], h[3]); *((GAS v2u*)(HM + (size_t)m * DM) + lane + 64 * j) = w;
                if (!(rflags & 1)) {
#pragma unroll
                for (int e = 0; e < 16; ++e) { const f32x4 wv = *(const LAS f32x4*)(wrL + e * DM + col); lg[e] += h[0] * wv[0] + h[1] * wv[1] + h[2] * wv[2] + h[3] * wv[3]; } }
            }
            float a8[8], a4[4], a2[2], a1;
#pragma unroll
            for (int i = 0; i < 8; ++i) { const float snd = b5 ? lg[i] : lg[8 + i], kp = b5 ? lg[8 + i] : lg[i]; a8[i] = kp + __shfl_xor(snd, 32); }
#pragma unroll
            for (int i = 0; i < 4; ++i) { const float snd = b4 ? a8[i] : a8[4 + i], kp = b4 ? a8[4 + i] : a8[i]; a4[i] = kp + __shfl_xor(snd, 16); }
#pragma unroll
            for (int i = 0; i < 2; ++i) { const float snd = b3 ? a4[i] : a4[2 + i], kp = b3 ? a4[2 + i] : a4[i]; a2[i] = kp + __shfl_xor(snd, 8); }
            { const float snd = b2 ? a2[0] : a2[1], kp = b2 ? a2[1] : a2[0]; a1 = kp + __shfl_xor(snd, 4); }
            a1 += __shfl_xor(a1, 2); a1 += __shfl_xor(a1, 1);
            if ((lane & 3) == 0) lgbuf[((it * 2 + q) & 15) * 16 + (lane >> 2)] = a1;
        }
#pragma unroll
        for (int q = 0; q < 2; ++q)
#pragma unroll
            for (int j = 0; j < 4; ++j) { cx[q][j] = nx[q][j]; ch[q][j] = nh[q][j]; cy[q][j] = ny[q][j]; }
    }
#undef ROUTE_LOAD
    LDS_WAIT();
    const int ntok = it * 2;
    int i0 = 0, i1 = 0, lp0 = 0, lp1 = 0; int mtok = -1;
    if (lane < ntok && !(rflags & 4)) {
        mtok = (gw + (lane >> 1) * NGW) * 2 + (lane & 1);
        float lg[16];
#pragma unroll
        for (int e = 0; e < 16; ++e) lg[e] = lgbuf[lane * 16 + e];
        float mx = lg[0];
#pragma unroll
        for (int e = 1; e < 16; ++e) mx = fmaxf(mx, lg[e]);
        float pr[16], sum = 0.f;
#pragma unroll
        for (int e = 0; e < 16; ++e) { pr[e] = __expf(lg[e] - mx); sum += pr[e]; }
        const float inv = 1.f / sum;
        float sel[16];
#pragma unroll
        for (int e = 0; e < 16; ++e) { pr[e] *= inv; sel[e] = pr[e] + br[e]; }
        int gb = 0; float gbest = -INFINITY;
#pragma unroll
        for (int g = 0; g < 4; ++g) {
            const float a = sel[4 * g], bq = sel[4 * g + 1], c = sel[4 * g + 2], d = sel[4 * g + 3];
            const float hi1 = fmaxf(a, bq), lo1 = fminf(a, bq), hi2 = fmaxf(c, d), lo2 = fminf(c, d);
            const float top = fmaxf(hi1, hi2), second = fmaxf(fminf(hi1, hi2), fmaxf(lo1, lo2));
            const float sc = top + second;
            if (sc > gbest) { gbest = sc; gb = g; }
        }
        float s0 = -INFINITY, s1 = -INFINITY; float p0 = 0.f, p1 = 0.f;
#pragma unroll
        for (int e = 0; e < 16; ++e) {
            if ((e >> 2) == gb) {
                const float sv = sel[e];
                if (sv > s0) { s1 = s0; i1 = i0; p1 = p0; s0 = sv; i0 = e; p0 = pr[e]; }
                else if (sv > s1) { s1 = sv; i1 = e; p1 = pr[e]; }
            }
        }
        const float wn = 1.f / (p0 + p1);
        IDX[mtok * 2] = i0; IDX[mtok * 2 + 1] = i1; WTS[mtok * 2] = p0 * wn; WTS[mtok * 2 + 1] = p1 * wn;
        lp0 = __hip_atomic_fetch_add(&lcnt[i0], 1, __ATOMIC_RELAXED, __HIP_MEMORY_SCOPE_WORKGROUP); lp1 = __hip_atomic_fetch_add(&lcnt[i1], 1, __ATOMIC_RELAXED, __HIP_MEMORY_SCOPE_WORKGROUP);
    }
    __syncthreads();
    if (F.tid < NE) lcnt[16 + F.tid] = atomicAdd(cnt + F.tid * 64, lcnt[F.tid]);
    __syncthreads();
    if (mtok >= 0) { int* BT = (int*)(F.smallf + SW_BT); const int q0 = lp0 + lcnt[16 + i0], q1 = lp1 + lcnt[16 + i1];
        POS[mtok * 2] = q0; POS[mtok * 2 + 1] = q1; BT[i0 * BT_CAP + q0] = mtok; BT[i1 * BT_CAP + q1] = mtok; }
}
__device__ __forceinline__ int moe_pstart(const int* cnt, int e) { int s = 0; for (int q = 0; q < e; ++q) s += ((cnt[q * 64] + 255) >> 8) << 8; return s; }

__device__ __forceinline__ int moe_build_table(Frame& F, int layer) {
    const int* cnt = (const int*)(F.ctl + CW_MOECNT + layer * 1024);
    LAS int* tab = (LAS int*)(F.lds + LDS_TAB_OFF);
    int nb = 0;
    for (int e = 0; e < NE; ++e) { const int c = cnt[e * 64], k = (c + 255) >> 8; if (F.tid < k) tab[nb + F.tid] = e | (F.tid << 4); if (F.tid == 0) { tab[256 + e] = c; tab[272 + e] = nb * 256; } nb += k; }
    __syncthreads();
    return nb;
}
struct SchedMoe {
    const char* A; const char* W; char* O; LAS const int* tab; const int* buftok; int gather; int lda, ldb, ldc, ocols, wrows;
    int nbx4, blk0, Gx, j, x, split, base, R, qh, Hn, Lc;
    __device__ __forceinline__ void map(int nb, int G, int c, int split_) {
        x = c & 7; j = c >> 3; Gx = (G + 7 - x) >> 3; const int q = nb >> 3, r = nb & 7; nbx4 = 4 * (q + (x < r ? 1 : 0)); blk0 = x * q + (x < r ? x : r);
        split = split_; base = nbx4 / Gx; R = nbx4 - base * Gx; qh = base >= 1 ? base - 1 : 0; Hn = R * qh; Lc = Gx - R; }
    __device__ __forceinline__ int off(int i) const {
        if (!split) { const int o = j + Gx * i; return o < nbx4 ? o : -1; }
        if (j < R) return i < qh ? nbx4 - Hn + i * R + j : -1;
        const int o = i * Lc + (j - R); return o < nbx4 - Hn ? o : -1; }
    __device__ __forceinline__ int count() const { int n = 0; while (off(n) >= 0) ++n; return n; }
    __device__ __forceinline__ bool next(int i, const char*& a, const char*& b) const {
        const int o = off(i); if (o < 0) return false; const int rb = blk0 + (o >> 2), pn = o & 3; const int e = __builtin_amdgcn_readfirstlane(tab[rb]) & 15;
        a = gather ? A : A + (size_t)rb * 256 * lda * 2; b = W + ((size_t)e * wrows + pn * 256) * ldb * 2; return true; }
    __device__ __forceinline__ void load_tokens(int i, LAS int* dst, int tid) const { const int rb = blk0 + (off(i) >> 2); const int t = tab[rb], e = t & 15, p = (t >> 4) * 256 + tid;
        if (tid < 256) dst[tid] = p < tab[256 + e] ? buftok[e * BT_CAP + p] : 0; }
    __device__ __forceinline__ void info(int i, EU& e) const { const int o = off(i); const int rb = blk0 + (o >> 2), pn = o & 3;
        e.o = O + ((size_t)rb * 256 * ldc + pn * ocols) * 2; e.ldc = ldc; e.cs = nullptr; e.rw = nullptr; e.rs = nullptr; e.rs2 = nullptr; e.rstride = 0; e.rslot = 0; e.causal = 0; }
};
constexpr int CW_XCCTAB = CW_LCNT + 2048;
constexpr int CW_SIG = CW_LCNT + 1024;
__device__ __forceinline__ void moe_signal(unsigned* gctr, LAS unsigned* lctr, bool lane0, bool samex) {
    asm volatile("s_waitcnt vmcnt(0)" ::: "memory");
    if (lane0) {
        const unsigned old = __hip_atomic_fetch_add(lctr, 1u, __ATOMIC_ACQ_REL, __HIP_MEMORY_SCOPE_WORKGROUP);
        if (old == NWAVES - 1) { __hip_atomic_store(lctr, 0u, __ATOMIC_RELAXED, __HIP_MEMORY_SCOPE_WORKGROUP); if (!samex) __builtin_amdgcn_fence(__ATOMIC_RELEASE, "agent"); (void)xb_add(gctr, 1u); }
    }
}
__device__ __forceinline__ bool moe_group_same_xcd(Frame& F, int x, int Gx) {
    const unsigned* tab = F.ctl + CW_XCCTAB; const unsigned mine = xb_xcc_id(); bool same = true;
    for (int jj = 0; jj < Gx; ++jj) same = same && (tab[x + 8 * jj] == mine);
    return same;
}
__device__ __forceinline__ void moe_wait_first(Frame& F, const SchedMoe& S2, bool samex, int sigofs = 0) {
    unsigned* sig = F.ctl + CW_SIG + sigofs;
    bool need2 = false;
    for (int i = 0; ; ++i) { const int o = S2.off(i); if (o < 0) break; if (S2.R > 0 && (o | 3) >= S2.base * S2.Gx) need2 = true; }
    if (S2.base >= 1) { unsigned sp = 0; while (xb_ld(sig + 64 * S2.x) < (unsigned)S2.Gx) { __builtin_amdgcn_s_sleep(2); if (++sp > XB_SPIN_CAP) break; } }
    if (need2) { unsigned sp = 0; while (xb_ld(sig + 512 + 64 * S2.x) < (unsigned)S2.R) { __builtin_amdgcn_s_sleep(2); if (++sp > XB_SPIN_CAP) break; } }
    if (samex) asm volatile("buffer_inv sc0" ::: "memory");
    else __builtin_amdgcn_fence(__ATOMIC_ACQUIRE, "agent");
    __syncthreads();
}
struct EpiMoe1 {
    static constexpr bool PERM = true;
    SchedMoe S; unsigned* sig; LAS unsigned* lctr; bool samex;
    __device__ __forceinline__ void operator()(const pg8::f32x4 (&acc)[2][2][4][2], int ui, int wr, int wc, int fr, int fq) const {
        EU e = {}; S.info(ui, e); asm volatile("" : "+s"(e.ldc));
        bf16* base = (bf16*)e.o; const int colb = wc * 32 + 8 * fq;
#pragma unroll
        for (int ai = 0; ai < 2; ++ai)
#pragma unroll
            for (int m = 0; m < 4; ++m) {
                const int row = ai * 128 + wr * 64 + m * 16 + fr;
                float r[8];
#pragma unroll
                for (int j = 0; j < 8; ++j) { const float g = acc[ai][0][m][j >> 2][j & 3], u = acc[ai][1][m][j >> 2][j & 3]; r[j] = silu_f(g) * u; }
                v4u w; w.x = pg8::cvt_pk_bf16(r[0], r[1]); w.y = pg8::cvt_pk_bf16(r[2], r[3]); w.z = pg8::cvt_pk_bf16(r[4], r[5]); w.w = pg8::cvt_pk_bf16(r[6], r[7]);
                *(v4u*)(base + (unsigned)(row * e.ldc + colb)) = w;
            }
        if (sig) { if (ui == S.base - 1) moe_signal(sig + 64 * S.x, lctr, (fr | fq) == 0, samex); else if (ui == S.base) moe_signal(sig + 512 + 64 * S.x, lctr, (fr | fq) == 0, samex); }
    }
};
__device__ __forceinline__ void moe_combine_phase(Frame& F, const bf16* HM, const bf16* YS, float* XO, int layer, int lnidx, bf16* H1, bf16* HKV) {
    const float* lng = KIN(F, I_LNG) + lnidx * DM; const float* lnb = KIN(F, I_LNB) + lnidx * DM; const float* cond = F.ctlf + CW_COND;
    const float* WTS = F.smallf + SW_WTS; const int* POS = (const int*)(F.smallf + SW_POS); const int* IDX = (const int*)(F.smallf + SW_IDX);
    LAS int* pst = (LAS int*)(F.lds + LDS_TAB_OFF) + 272;
    if (F.tid < NE) pst[F.tid] = moe_pstart((const int*)(F.ctl + CW_MOECNT + layer * 1024), F.tid);
    const int gw = F.bx * NWAVES + F.wave, NGW = F.G * NWAVES, lane = F.lane;
    LAS float* prm = (LAS float*)(F.lds + RING_OFF);
    for (int i = F.tid; i < 2 * DM; i += NTHR) { const int b = i >> 10, col = i & 1023; const float* cb = cond + b * NMOD; LAS float* pb = prm + b * 7 * DM + col;
        const float g_ = lng[col], b_ = lnb[col];
        pb[0] = DN_ALPHA * __builtin_amdgcn_rcpf(cb[mod_off(layer, 1, 1) + col] + 1.f); pb[DM] = cb[mod_off(layer, 1, 0) + col]; pb[2 * DM] = cb[mod_off(layer, 1, 2) + col] + 1.f;
        if (H1) { const float sc1 = cb[mod_off(layer + 1, 0, 1) + col] + 1.f, sc2 = cb[13 * DM + col] + 1.f;
            pb[3 * DM] = g_ * sc1; pb[4 * DM] = b_ * sc1 + cb[mod_off(layer + 1, 0, 0) + col]; pb[5 * DM] = g_ * sc2; pb[6 * DM] = b_ * sc2 + cb[12 * DM + col]; }
        else { pb[3 * DM] = g_; pb[4 * DM] = b_; } }
    __syncthreads();
    int rrN[2][2]; float wwN[2][2]; v2u xN[2][4], yaN[2][4], ycN[2][4];
#define CMB_IDX(mp_, R_, W_) do { _Pragma("unroll") for (int q_ = 0; q_ < 2; ++q_) { const int m_ = (mp_) * 2 + q_; R_[q_][0] = POS[m_ * 2] + pst[IDX[m_ * 2]]; R_[q_][1] = POS[m_ * 2 + 1] + pst[IDX[m_ * 2 + 1]]; W_[q_][0] = WTS[m_ * 2]; W_[q_][1] = WTS[m_ * 2 + 1]; } } while (0)
#define CMB_ROWS(mp_, R_, X_, A_, C_) do { _Pragma("unroll") for (int q_ = 0; q_ < 2; ++q_) _Pragma("unroll") for (int j_ = 0; j_ < 4; ++j_) { \
        X_[q_][j_] = *((const GAS v2u*)(HM + (size_t)((mp_) * 2 + q_) * DM) + lane + 64 * j_); A_[q_][j_] = *((const GAS v2u*)(YS + (size_t)R_[q_][0] * DM) + lane + 64 * j_); C_[q_][j_] = *((const GAS v2u*)(YS + (size_t)R_[q_][1] * DM) + lane + 64 * j_); } } while (0)
    if (gw < M / 2) { CMB_IDX(gw, rrN, wwN); CMB_ROWS(gw, rrN, xN, yaN, ycN); }
    for (int mp = gw; mp < M / 2; mp += NGW) {
        const int m0 = mp * 2;
        const int b = m0 / SEQ; LAS const float* pb = prm + b * 7 * DM;
        float ww[2][2]; v2u x[2][4], ya[2][4], yc[2][4];
#pragma unroll
        for (int q = 0; q < 2; ++q) { ww[q][0] = wwN[q][0]; ww[q][1] = wwN[q][1];
#pragma unroll
            for (int j = 0; j < 4; ++j) { x[q][j] = xN[q][j]; ya[q][j] = yaN[q][j]; yc[q][j] = ycN[q][j]; } }
        if (mp + NGW < M / 2) { CMB_IDX(mp + NGW, rrN, wwN); CMB_ROWS(mp + NGW, rrN, xN, yaN, ycN); }
#pragma unroll
        for (int q = 0; q < 2; ++q) {
            const int m = m0 + q; f32x4 v[4];
#pragma unroll
            for (int j = 0; j < 4; ++j) { const int col = 4 * lane + 256 * j;
                const f32x4 a = (f32x4){bflo(ya[q][j].x), bfhi(ya[q][j].x), bflo(ya[q][j].y), bfhi(ya[q][j].y)}, c = (f32x4){bflo(yc[q][j].x), bfhi(yc[q][j].x), bflo(yc[q][j].y), bfhi(yc[q][j].y)};
                const f32x4 hv = (f32x4){bflo(x[q][j].x), bfhi(x[q][j].x), bflo(x[q][j].y), bfhi(x[q][j].y)};
                v[j] = (hv - *(LAS const f32x4*)(pb + DM + col)) * *(LAS const f32x4*)(pb + col) + *(LAS const f32x4*)(pb + 2 * DM + col) * (a * ww[q][0] + c * ww[q][1]); }
            float s = 0.f;
#pragma unroll
            for (int j = 0; j < 4; ++j) s += (v[j][0] + v[j][1]) + (v[j][2] + v[j][3]);
            const float mean = wave_sum_dpp(s) * (1.f / DM); float s2 = 0.f;
#pragma unroll
            for (int j = 0; j < 4; ++j) { v[j] = v[j] - mean; s2 += (v[j][0] * v[j][0] + v[j][1] * v[j][1]) + (v[j][2] * v[j][2] + v[j][3] * v[j][3]); }
            const float rstd = rsqrtf(wave_sum_dpp(s2) * (1.f / DM) + LN_EPS);
#pragma unroll
            for (int j = 0; j < 4; ++j) { const int col = 4 * lane + 256 * j; const f32x4 n = v[j] * rstd;
                const f32x4 h = n * *(LAS const f32x4*)(pb + 3 * DM + col) + *(LAS const f32x4*)(pb + 4 * DM + col);
                if (XO) *((GAS f32x4*)(XO + (size_t)m * DM) + lane + 64 * j) = h;
                if (H1) { v2u w; w.x = pk2(h[0], h[1]); w.y = pk2(h[2], h[3]); *((GAS v2u*)(H1 + (size_t)m * DM) + lane + 64 * j) = w; }
                if (HKV) { const f32x4 h2 = n * *(LAS const f32x4*)(pb + 5 * DM + col) + *(LAS const f32x4*)(pb + 6 * DM + col);
                    v2u w; w.x = pk2(h2[0], h2[1]); w.y = pk2(h2[2], h2[3]); *((GAS v2u*)(HKV + (size_t)m * DM) + lane + 64 * j) = w; }
            }
        }
    }
#undef CMB_IDX
#undef CMB_ROWS
}
constexpr int LIST_CAP = 7936;
struct SchedQKV1 {
    const char* H1; const char* HKV; const char* Wq; const char* Wkv; char* Q1; char* K1; char* VT; float* KM; int G, c;
    __device__ __forceinline__ void dec(int i, int& ty, int& pm, int& pn) const { const int L = xremap(i * G + c, 768); ty = L >> 8; const int r = L & 255; if (ty < 2) { pm = r >> 2; pn = r & 3; } else { pm = r & 3; pn = r >> 2; } }
    __device__ __forceinline__ bool next(int i, const char*& a, const char*& b) const {
        if (i * G + c >= 768) return false; int ty, pm, pn; dec(i, ty, pm, pn);
        if (ty == 0) { a = H1 + (size_t)pm * 256 * DM * 2; b = Wq + (size_t)pn * 256 * DM * 2; }
        else if (ty == 1) { a = HKV + (size_t)pm * 256 * DM * 2; b = Wkv + (size_t)pn * 256 * DM * 2; }
        else { a = Wkv + (size_t)(DM + pm * 256) * DM * 2; b = HKV + (size_t)pn * 256 * DM * 2; }
        return true; }
    __device__ __forceinline__ void info(int i, EU& e) const { int ty, pm, pn; dec(i, ty, pm, pn);
        e.cs = nullptr; e.rw = nullptr; e.rs = nullptr; e.rs2 = nullptr; e.rstride = 0; e.rslot = 0; e.causal = 0; e.csum = nullptr;
        if (ty == 0) { e.o = Q1 + ((size_t)pm * 256 * DM + pn * 256) * 2; e.ldc = DM; }
        else if (ty == 1) { e.o = K1 + ((size_t)pm * 256 * DM + pn * 256) * 2; e.ldc = DM; e.csum = KM + ((size_t)pm * DM + pn * 256) * 2; }
        else { e.o = VT + ((size_t)pm * 256 * M + pn * 256) * 2; e.ldc = M; } }
};

struct EpiQKV1 {
    static constexpr bool PERM = true;
    SchedQKV1 S; float* KNP;
    __device__ __forceinline__ void operator()(const pg8::f32x4 (&acc)[2][2][4][2], int ui, int wr, int wc, int fr, int fq) const {
        int ty, pm, pn; S.dec(ui, ty, pm, pn);
        char* o; int ldc;
        if (ty == 0) { o = S.Q1 + ((size_t)pm * 256 * DM + pn * 256) * 2; ldc = DM; }
        else if (ty == 1) { o = S.K1 + ((size_t)pm * 256 * DM + pn * 256) * 2; ldc = DM; }
        else { o = S.VT + ((size_t)pm * 256 * M + pn * 256) * 2; ldc = M; }
        asm volatile("" : "+s"(ldc));
        bf16* base = (bf16*)o; const int colb = wc * 32 + 8 * fq;
        float pmax[2] = {0.f, 0.f};
#pragma unroll
        for (int ai = 0; ai < 2; ++ai)
#pragma unroll
            for (int m = 0; m < 4; ++m) {
                const int row = ai * 128 + wr * 64 + m * 16 + fr;
#pragma unroll
                for (int bj = 0; bj < 2; ++bj) { const f32x4 v0 = acc[ai][bj][m][0], v1 = acc[ai][bj][m][1];
                    v4u w; w.x = pg8::cvt_pk_bf16(v0[0], v0[1]); w.y = pg8::cvt_pk_bf16(v0[2], v0[3]); w.z = pg8::cvt_pk_bf16(v1[0], v1[1]); w.w = pg8::cvt_pk_bf16(v1[2], v1[3]);
                    *(v4u*)(base + (unsigned)(row * ldc + bj * 128 + colb)) = w;
                    if (ty == 1) { float s = (v0[0] * v0[0] + v0[1] * v0[1]) + (v0[2] * v0[2] + v0[3] * v0[3]) + (v1[0] * v1[0] + v1[1] * v1[1]) + (v1[2] * v1[2] + v1[3] * v1[3]);
                        s += __shfl_xor(s, 16); s += __shfl_xor(s, 32); pmax[bj] = fmaxf(pmax[bj], s); } }
            }
        if (ty == 1) {
#pragma unroll
            for (int bj = 0; bj < 2; ++bj) { float p = pmax[bj]; p = fmaxf(p, __shfl_xor(p, 1)); p = fmaxf(p, __shfl_xor(p, 2)); p = fmaxf(p, __shfl_xor(p, 4)); p = fmaxf(p, __shfl_xor(p, 8));
                if (fr == 0 && fq == 0) KNP[(((size_t)pm * AH + pn * 4 + bj * 2 + (wc >> 1)) * 2 + (wc & 1)) * 2 + wr] = p; }
            float* csum = S.KM + ((size_t)pm * DM + pn * 256) * 2;
            unsigned cbl = (unsigned)(colb * 2 + wr); asm volatile("" : "+v"(cbl));
#pragma unroll
            for (int bj = 0; bj < 2; ++bj)
#pragma unroll
                for (int n = 0; n < 2; ++n) { f32x4 c4 = (f32x4){0.f, 0.f, 0.f, 0.f};
#pragma unroll
                    for (int ai = 0; ai < 2; ++ai)
#pragma unroll
                        for (int m = 0; m < 4; ++m) c4 += acc[ai][bj][m][n];
#pragma unroll
                    for (int j = 0; j < 4; ++j) { float v = c4[j]; v += __shfl_xor(v, 1); v += __shfl_xor(v, 2); v += __shfl_xor(v, 4); v += __shfl_xor(v, 8);
                        if (fr == 0) csum[cbl + (unsigned)((bj * 128 + 4 * n + j) * 2)] = v; } }
        }
    }
};

__device__ __forceinline__ void moba_keynorm_phase(Frame& F) {
    LAS float* red = (LAS float*)(F.lds + RING_OFF);
    const bf16* K1 = (const bf16*)((const char*)F.out + 32 * MiB); float* KN = F.ctlf + CW_KN;
    for (int u0 = F.bx * 2; u0 < BATCH * AH * NBLK; u0 += F.G * 2) {
        const int u = u0 + (F.tid >> 8), b = u >> 9, h = (u >> 5) & 15, n = u & 31, r = F.tid & 255;
        const v4u* kp = (const v4u*)(K1 + (size_t)(b * SEQ + n * 256 + r) * DM + h * HD); float s = 0.f;
#pragma unroll
        for (int i = 0; i < 8; ++i) { const v4u w = kp[i]; const float a0 = bflo(w.x), a1 = bfhi(w.x), a2 = bflo(w.y), a3 = bfhi(w.y), a4 = bflo(w.z), a5 = bfhi(w.z), a6 = bflo(w.w), a7 = bfhi(w.w);
            s += a0 * a0 + a1 * a1 + a2 * a2 + a3 * a3 + a4 * a4 + a5 * a5 + a6 * a6 + a7 * a7; }
#pragma unroll
        for (int o = 1; o < 64; o <<= 1) s = fmaxf(s, __shfl_xor(s, o));
        __syncthreads();
        if (F.lane == 0) red[F.wave] = s;
        __syncthreads();
        if ((F.tid & 255) == 0) { const int w0 = (F.tid >> 8) * 4; KN[u] = sqrtf(fmaxf(fmaxf(red[w0], red[w0 + 1]), fmaxf(red[w0 + 2], red[w0 + 3]))) * 1.01f + 1e-3f; }
    }
    __syncthreads();
}
__device__ __forceinline__ void moba_route_phase(Frame& F, int cslot) {
    const int half = F.tid >> 8, ht = F.tid & 255;
    LAS float* km = (LAS float*)(F.lds + RING_OFF) + half * (32 * 64 + 128);
    LAS int* lcnt = (LAS int*)(km + 32 * 64);
    LAS int* lbase = lcnt + 32;
    LAS float* kn = (LAS float*)(lbase + 32);
    const float* KM = F.ctlf + CW_KM; const float* KNP = F.ctlf + CW_KNP; const bf16* Q1 = (const bf16*)F.out;
    int* LCNT = (int*)(F.ctl + CW_LCNT + cslot * 1024); int* LISTS = (int*)(F.ws + WS_LISTS); float* LSE = (float*)(F.ws + WS_LSE);
    for (int u0 = F.bx * 2; u0 < BATCH * AH * NBLK; u0 += F.G * 2) {
        const int u = u0 + half, b = u >> 9, h = (u >> 5) & 15, j = (u & 31) ^ (((u0 / (F.G * 2)) & 1) ? 31 : 0);
        __syncthreads();
        for (int i = ht; i < j * 64; i += 256) { const int n = i >> 6, d = i & 63; const float* p = KM + ((size_t)(b * NBLK + n) * DM + h * HD + d) * 2; km[i] = (p[0] + p[1]) * (1.f / 256.f); }
        if (ht < 32) { lcnt[ht] = 0; const float* p = KNP + ((size_t)((b * NBLK + ht) * AH + h)) * 4; kn[ht] = sqrtf(fmaxf(p[0], p[1]) + fmaxf(p[2], p[3])) * 1.01f + 1e-3f; }
        __syncthreads();
        int sel[3] = {0, 0, 0}, pos[3] = {-1, -1, -1}; const int nsel = j < 3 ? j : 3;
        const float slope2 = exp2f(-0.5f * (float)(h + 1)) * LOG2E;
        if (j > 0) {
            const int t = j * 256 + ht;
            float q[64];
            const v4u* qp = (const v4u*)(Q1 + (size_t)(b * SEQ + t) * DM + h * HD);
#pragma unroll
            for (int i = 0; i < 8; ++i) { const v4u w = qp[i]; q[8 * i] = bflo(w.x); q[8 * i + 1] = bfhi(w.x); q[8 * i + 2] = bflo(w.y); q[8 * i + 3] = bfhi(w.y); q[8 * i + 4] = bflo(w.z); q[8 * i + 5] = bfhi(w.z); q[8 * i + 6] = bflo(w.w); q[8 * i + 7] = bfhi(w.w); }
            float qq = 0.f;
#pragma unroll
            for (int d = 0; d < 64; ++d) qq += q[d] * q[d];
            const float qn = sqrtf(qq) * 1.01f + 1e-3f;
            float s0 = -INFINITY, s1 = -INFINITY, s2 = -INFINITY;
            for (int n = 0; n < j; ++n) {
                float s = 0.f;
#pragma unroll
                for (int d = 0; d < 64; ++d) s += q[d] * km[n * 64 + d];
                if (s > s0) { s2 = s1; sel[2] = sel[1]; s1 = s0; sel[1] = sel[0]; s0 = s; sel[0] = n; }
                else if (s > s1) { s2 = s1; sel[2] = sel[1]; s1 = s; sel[1] = n; }
                else if (s > s2) { s2 = s; sel[2] = n; }
            }
            for (int k = 0; k < nsel; ++k) {
                const float dmin = (float)(t - (sel[k] * 256 + 255));
                const bool dead = slope2 * dmin - qn * (kn[sel[k]] + kn[j]) - 8.f > 150.f;
                if (dead) LSE[((size_t)(b * SEQ + t) * AH + h) * 4 + k] = -INFINITY;
                else pos[k] = __hip_atomic_fetch_add(&lcnt[sel[k]], 1, __ATOMIC_RELAXED, __HIP_MEMORY_SCOPE_WORKGROUP);
            }
        }
        __syncthreads();
        if (ht < j) lbase[ht] = atomicAdd(LCNT + (b * AH + h) * NBLK + ht, lcnt[ht]);
        __syncthreads();
        for (int k = 0; k < nsel; ++k) if (pos[k] >= 0) LISTS[(size_t)((b * AH + h) * NBLK + sel[k]) * LIST_CAP + lbase[sel[k]] + pos[k]] = ((j * 256 + ht) << 2) | k;
    }
    __syncthreads();
}

__device__ __forceinline__ int crow16(int r, int hi) { return (r & 3) + 8 * (r >> 2) + 4 * hi; }
constexpr int AT_KS = 0, AT_KSTRIDE = 144, AT_VS = 36864, AT_VSTRIDE = 528, AT_STG = 70656, AT_WSF = 103424, AT_PFX = 106496, AT_DUMMY = 114688, AT_ENP = 116736;
constexpr int AT_SEG = 2;
__device__ __forceinline__ void attn_kv_load(Frame& F, int b, int h, int kblk, v4u (&kv)[8]) {
    const bf16* K1 = (const bf16*)((const char*)F.out + 32 * MiB); const bf16* VT = (const bf16*)(F.ws + WS_VT1);
    const int tid = F.tid, r = tid >> 1, half = tid & 1, d = tid >> 3, seg = tid & 7;
    const v4u* src = (const v4u*)(K1 + (size_t)(b * SEQ + kblk * 256 + r) * DM + h * HD + half * 32);
    const v4u* vsrc = (const v4u*)(VT + (size_t)(h * HD + d) * M + b * SEQ + kblk * 256 + seg * 32);
#pragma unroll
    for (int i = 0; i < 4; ++i) { kv[i] = src[i]; kv[4 + i] = vsrc[i]; }
}
__device__ __forceinline__ void attn_unit(Frame& F, int b, int h, int kblk, bool own, const int* list, int cnt, int chunk0, int nchunk, v4u (&kv)[8], bool has_next, int nb_, int nh_, int nkblk_, bool pre_, bool nown_, const int* nlist_, int nchunk0_, int tflags = 0) {
    const bf16* Q1 = (const bf16*)F.out;
    bf16* PART = (bf16*)(F.ws + WS_PART); float* LSE = (float*)(F.ws + WS_LSE);
    LAS unsigned char* ring = F.lds + RING_OFF;
    const int tid = F.tid, lane = F.lane, wave = F.wave, r32 = lane & 31, hi = lane >> 5;
    const float slope2 = exp2f(-0.5f * (float)(h + 1)) * LOG2E;
    LAS float* wsf = (LAS float*)(ring + AT_WSF) + wave * 64;
    LAS bf16* stg = (LAS bf16*)(ring + AT_STG) + wave * 2048;
    int tq, slot; bool valid; bf16x8 qf[4];
    LAS const int* enl = (LAS const int*)(ring + AT_ENP) + wave * 64;
    auto load_q = [&](int chunk, int& tq_, int& slot_, bool& valid_, bf16x8 (&q_)[4], bool pre) {
        if (own) { tq_ = kblk * 256 + wave * 32 + r32; slot_ = 3; valid_ = true; }
        else { const int ei = chunk * 256 + wave * 32 + r32; valid_ = ei < cnt; const int en = valid_ ? (pre ? enl[lane] : list[ei]) : 0; tq_ = en >> 2; slot_ = en & 3; }
        const bf16x8* qp = (const bf16x8*)(Q1 + (size_t)(b * SEQ + tq_) * DM + h * HD + hi * 8);
#pragma unroll
        for (int ds = 0; ds < 4; ++ds) q_[ds] = qp[ds * 2];
    };
    if (pre_ && !own) asm volatile("s_waitcnt vmcnt(8)" ::: "memory");
    load_q(chunk0, tq, slot, valid, qf, pre_);
    LDS_WAIT();
    if (has_next && !nown_)
        __builtin_amdgcn_global_load_lds((const unsigned*)(nlist_ + nchunk0_ * 256 + wave * 32 + r32), (LAS unsigned*)(ring + AT_ENP + wave * 256), 4, 0, 0);
    if (has_next) {
        const char* gb; unsigned vo;
        if (wave < 4) { gb = (const char*)F.out + 32 * MiB + ((size_t)(nb_ * SEQ + nkblk_ * 256) * DM + nh_ * HD) * 2; vo = (unsigned)tid * (DM * 2); }
        else { gb = (const char*)(F.ws + WS_VT1) + ((size_t)(nh_ * HD) * M + nb_ * SEQ + nkblk_ * 256) * 2; vo = (unsigned)((tid - 256) >> 2) * (M * 2) + (unsigned)((tid - 256) & 3) * 128u; }
        __builtin_amdgcn_global_load_lds((const unsigned*)(gb + vo), (LAS unsigned*)(ring + AT_DUMMY + wave * 256), 4, 0, 0);
    }
    {
        const int r = tid >> 1, half = tid & 1;
        LAS v4u* dst = (LAS v4u*)(ring + AT_KS + r * AT_KSTRIDE + half * 64);
#pragma unroll
        for (int i = 0; i < 4; ++i) dst[i] = kv[i];
        const int d = tid >> 3, seg = tid & 7;
        LAS unsigned char* row = ring + AT_VS + d * AT_VSTRIDE;
#pragma unroll
        for (int i = 0; i < 4; ++i) { const v4u w = kv[4 + i]; const int g16 = seg * 2 + (i >> 1), hf = i & 1;
            *(LAS v2u*)(row + g16 * 32 + hf * 8) = (v2u){w.x, w.y}; *(LAS v2u*)(row + g16 * 32 + 16 + hf * 8) = (v2u){w.z, w.w}; }
    }
    __syncthreads();
    for (int ci = 0; ci < nchunk; ++ci) {
        int tqn = 0, slotn = 0; bool validn = false; bf16x8 qn[4];
        if (ci + 1 < nchunk) load_q(chunk0 + ci + 1, tqn, slotn, validn, qn, false);
        float m = -1e30f, l = 0.f;
        f32x16 o0, o1;
#pragma unroll
        for (int i = 0; i < 16; ++i) { o0[i] = 0.f; o1[i] = 0.f; }
        const int nkt = (tflags & 2) ? 0 : (own ? (wave >> 1) + 1 : 4);
        bf16x8 kf[8];
        if (nkt > 0) { const LAS unsigned char* kp = ring + AT_KS + ((nkt - 1) * 64 + r32) * AT_KSTRIDE + hi * 16;
#pragma unroll
            for (int ds = 0; ds < 4; ++ds) { kf[ds] = *(const LAS bf16x8*)(kp + ds * 32); kf[4 + ds] = *(const LAS bf16x8*)(kp + 32 * AT_KSTRIDE + ds * 32); } }
        for (int kt = nkt - 1; kt >= 0; --kt) {
            f32x16 p0, p1;
#pragma unroll
            for (int i = 0; i < 16; ++i) { p0[i] = 0.f; p1[i] = 0.f; }
#pragma unroll
            for (int ds = 0; ds < 4; ++ds) { p0 = __builtin_amdgcn_mfma_f32_32x32x16_bf16(kf[ds], qf[ds], p0, 0, 0, 0); p1 = __builtin_amdgcn_mfma_f32_32x32x16_bf16(kf[4 + ds], qf[ds], p1, 0, 0, 0); }
            if (kt > 0) { const LAS unsigned char* kp = ring + AT_KS + ((kt - 1) * 64 + r32) * AT_KSTRIDE + hi * 16;
#pragma unroll
                for (int ds = 0; ds < 4; ++ds) { kf[ds] = *(const LAS bf16x8*)(kp + ds * 32); kf[4 + ds] = *(const LAS bf16x8*)(kp + 32 * AT_KSTRIDE + ds * 32); } }
            bf16x8 vf[4];
            const LAS unsigned char* vp = ring + AT_VS + r32 * AT_VSTRIDE + kt * 128 + hi * 16;
#pragma unroll
            for (int sI = 0; sI < 2; ++sI) { vf[sI] = *(const LAS bf16x8*)(vp + sI * 32); vf[2 + sI] = *(const LAS bf16x8*)(vp + 32 * AT_VSTRIDE + sI * 32); }
            if (!(tflags & 4)) {
            const float c0 = slope2 * (float)(kblk * 256 + kt * 64 + 4 * hi - tq);
            float rm = -INFINITY;
            const bool diag = own && kt == nkt - 1;
            const int qrel = (wave & 1) * 32 + r32;
#pragma unroll
            for (int r = 0; r < 16; ++r) { const float bq = c0 + slope2 * (float)((r & 3) + 8 * (r >> 2)); p0[r] += bq; p1[r] += bq + 32.f * slope2; }
            if (diag) {
                int qr = qrel - 4 * hi; asm volatile("" : "+v"(qr) :: "memory");
#pragma unroll
                for (int r = 0; r < 16; ++r) { const int kr = (r & 3) + 8 * (r >> 2); if (kr > qr) p0[r] = -INFINITY; if (kr + 32 > qr) p1[r] = -INFINITY; }
            }
#pragma unroll
            for (int r = 0; r < 16; ++r) rm = __builtin_fmaxf(__builtin_fmaxf(rm, p0[r]), p1[r]);
            { auto rr = __builtin_amdgcn_permlane32_swap(__float_as_uint(rm), __float_as_uint(rm), false, false); rm = fmaxf(__uint_as_float(rr[0]), __uint_as_float(rr[1])); }
            const bool grow = rm > m;
            const float mn = fmaxf(m, rm); const float f = __builtin_amdgcn_exp2f(m - mn); m = mn; l *= f;
            float ps = 0.f;
#pragma unroll
            for (int r = 0; r < 16; ++r) { p0[r] = __builtin_amdgcn_exp2f(p0[r] - mn); p1[r] = __builtin_amdgcn_exp2f(p1[r] - mn); ps += p0[r] + p1[r]; }
            l += ps;
            if (__any(grow)) {
                if (hi == 0) wsf[r32] = f;
                LDS_WAIT();
#pragma unroll
                for (int i = 0; i < 16; ++i) { const float fi = wsf[crow16(i, hi)]; o0[i] *= fi; o1[i] *= fi; }
            }
            }
#pragma unroll
            for (int sI = 0; sI < 4; ++sI) { const f32x16& pp = (sI < 2) ? p0 : p1; const int q8 = (sI & 1) * 8;
                if (sI == 2) {
#pragma unroll
                    for (int s2 = 0; s2 < 2; ++s2) { vf[s2] = *(const LAS bf16x8*)(vp + (2 + s2) * 32); vf[2 + s2] = *(const LAS bf16x8*)(vp + 32 * AT_VSTRIDE + (2 + s2) * 32); } }
                v4u w; w.x = pg8::cvt_pk_bf16(pp[q8], pp[q8 + 1]); w.y = pg8::cvt_pk_bf16(pp[q8 + 2], pp[q8 + 3]); w.z = pg8::cvt_pk_bf16(pp[q8 + 4], pp[q8 + 5]); w.w = pg8::cvt_pk_bf16(pp[q8 + 6], pp[q8 + 7]);
                const bf16x8 pa = __builtin_bit_cast(bf16x8, w);
                o0 = __builtin_amdgcn_mfma_f32_32x32x16_bf16(pa, vf[sI & 1], o0, 0, 0, 0);
                o1 = __builtin_amdgcn_mfma_f32_32x32x16_bf16(pa, vf[2 + (sI & 1)], o1, 0, 0, 0); }
        }
        float lt; { auto rr = __builtin_amdgcn_permlane32_swap(__float_as_uint(l), __float_as_uint(l), false, false); lt = __uint_as_float(rr[0]) + __uint_as_float(rr[1]); }
        LDS_WAIT();
        if (hi == 0) wsf[r32] = 1.f / lt;
        LDS_WAIT();
#pragma unroll
        for (int i = 0; i < 16; ++i) { const int orow = crow16(i, hi); const float inv = wsf[orow];
            stg[orow * 64 + r32] = (bf16)f2bf(o0[i] * inv); stg[orow * 64 + 32 + r32] = (bf16)f2bf(o1[i] * inv); }
        LDS_WAIT();
        const int code = valid ? ((tq << 2) | slot) : -1;
#pragma unroll
        for (int i = 0; i < 4; ++i) { const int row = i * 8 + (lane >> 3), chn = lane & 7; const int cd = __shfl(code, row);
            const v4u v = *(const LAS v4u*)(stg + row * 64 + chn * 8);
            if (cd >= 0 && !(tflags & 1)) { const size_t prow = ((size_t)(b * SEQ + (cd >> 2)) * AH + h) * 4 + (cd & 3); *(v4u*)(PART + prow * HD + chn * 8) = v; } }
        if (hi == 0 && valid && !(tflags & 1)) LSE[((size_t)(b * SEQ + tq) * AH + h) * 4 + slot] = m + __builtin_amdgcn_logf(lt);
        LDS_WAIT();
        tq = tqn; slot = slotn; valid = validn;
#pragma unroll
        for (int ds = 0; ds < 4; ++ds) qf[ds] = qn[ds];
    }
    __syncthreads();
}

__device__ __forceinline__ void moba_attn_phase(Frame& F, int mode = 0, int tflags = 0) {
    const int* LCNT = (const int*)(F.ctl + CW_LCNT); const int* LISTS = (const int*)(F.ws + WS_LISTS);
    LAS int* pfx = (LAS int*)(F.lds + RING_OFF + AT_PFX);
    {
        const int c0 = (((LCNT[2 * F.tid] + 255) >> 8) + AT_SEG - 1) / AT_SEG, c1 = (((LCNT[2 * F.tid + 1] + 255) >> 8) + AT_SEG - 1) / AT_SEG;
        LAS int* tmp = pfx + 1032;
        tmp[F.tid] = c0 + c1; __syncthreads();
        for (int o = 1; o < NTHR; o <<= 1) { const int v = (F.tid >= o) ? tmp[F.tid - o] : 0; __syncthreads(); tmp[F.tid] += v; __syncthreads(); }
        const int incl = tmp[F.tid], excl = incl - (c0 + c1);
        pfx[2 * F.tid] = excl; pfx[2 * F.tid + 1] = excl + c0; if (F.tid == NTHR - 1) pfx[1024] = incl;
        __syncthreads();
    }
    const int nsegs = pfx[1024], total = 1024 + nsegs;
    const int ubeg = (mode == 1 ? nsegs + F.bx : F.bx), uend = (mode == 2 ? nsegs : total);
#define AT_DECODE(u_, ok_, b_, h_, kb_, own_, li_, cnt_, c0_, nc_) do { ok_ = (u_) < uend; b_ = 0; h_ = 0; kb_ = 0; own_ = false; li_ = 0; cnt_ = 0; c0_ = 0; nc_ = 1; \
        if (ok_) { if ((u_) < nsegs) { int lo = 0, hi_ = 1023; while (lo < hi_) { const int mid = (lo + hi_ + 1) >> 1; if (pfx[mid] <= (u_)) lo = mid; else hi_ = mid - 1; } \
                li_ = __builtin_amdgcn_readfirstlane(lo); const int seg_ = __builtin_amdgcn_readfirstlane((u_) - pfx[li_]); cnt_ = LCNT[li_]; const int nch_ = (cnt_ + 255) >> 8; c0_ = seg_ * AT_SEG; nc_ = (nch_ - c0_) < AT_SEG ? (nch_ - c0_) : AT_SEG; \
                b_ = li_ >> 9; h_ = (li_ >> 5) & 15; kb_ = li_ & 31; } \
            else { const int v_ = (u_) - nsegs; own_ = true; b_ = v_ >> 9; h_ = (v_ >> 5) & 15; kb_ = v_ & 31; } } } while (0)
    bool ok, own; int ub, uh, ukb, uli, ucnt, uc0, unc;
    int u = ubeg;
    AT_DECODE(u, ok, ub, uh, ukb, own, uli, ucnt, uc0, unc);
    bool pre = false;
    while (ok) {
        v4u kv[8];
        attn_kv_load(F, ub, uh, ukb, kv);
        bool ok2, own2; int b2, h2, kb2, li2, cnt2, c02, nc2;
        AT_DECODE(u + F.G, ok2, b2, h2, kb2, own2, li2, cnt2, c02, nc2);
        attn_unit(F, ub, uh, ukb, own, LISTS + (size_t)uli * LIST_CAP, ucnt, uc0, unc, kv, ok2, b2, h2, kb2, pre, own2, LISTS + (size_t)li2 * LIST_CAP, c02, tflags); pre = true;
        ok = ok2; own = own2; ub = b2; uh = h2; ukb = kb2; uli = li2; ucnt = cnt2; uc0 = c02; unc = nc2; u += F.G;
    }
#undef AT_DECODE
}

__device__ __forceinline__ void moba_combine_phase(Frame& F) {
    const bf16* PART = (const bf16*)(F.ws + WS_PART); const float* LSE = (const float*)(F.ws + WS_LSE); bf16* OB = (bf16*)(F.ws + WS_OB);
    const int gt = F.bx * NTHR + F.tid, NGT = F.G * NTHR;
    for (int e = gt; e < M * AH * 8; e += NGT) {
        const int chn = e & 7, th = e >> 3, hh = th & 15, m = th >> 4; const int j = (m % SEQ) >> 8; const int nsel = j < 3 ? j : 3;
        const float* ls = LSE + (size_t)th * 4;
        float lv[4]; lv[3] = ls[3]; float mx = lv[3];
#pragma unroll
        for (int k = 0; k < 3; ++k) { lv[k] = (k < nsel) ? ls[k] : -INFINITY; mx = fmaxf(mx, lv[k]); }
        v4u pp[4];
#pragma unroll
        for (int k = 0; k < 4; ++k) { pp[k] = (v4u){0u, 0u, 0u, 0u}; if ((k == 3 || k < nsel) && lv[k] > -INFINITY) pp[k] = *(const v4u*)(PART + ((size_t)th * 4 + k) * HD + chn * 8); }
        float acc[8], wsum = 0.f;
#pragma unroll
        for (int i = 0; i < 8; ++i) acc[i] = 0.f;
#pragma unroll
        for (int k = 0; k < 4; ++k) {
            const bool use = (k == 3 || k < nsel) && lv[k] > -INFINITY;
            const float w = use ? exp2f(lv[k] - mx) : 0.f; wsum += w;
            const v4u p = pp[k];
            if (use) { acc[0] += w * bflo(p.x); acc[1] += w * bfhi(p.x); acc[2] += w * bflo(p.y); acc[3] += w * bfhi(p.y); acc[4] += w * bflo(p.z); acc[5] += w * bfhi(p.z); acc[6] += w * bflo(p.w); acc[7] += w * bfhi(p.w); }
        }
        const float inv = 1.f / wsum;
        v4u o; o.x = pk2(acc[0] * inv, acc[1] * inv); o.y = pk2(acc[2] * inv, acc[3] * inv); o.z = pk2(acc[4] * inv, acc[5] * inv); o.w = pk2(acc[6] * inv, acc[7] * inv);
        *(v4u*)(OB + (size_t)m * DM + hh * HD + chn * 8) = o;
    }
}
__global__ void __launch_bounds__(NTHR, 2) mk_fwd(Args args) {
    extern __shared__ __attribute__((aligned(16))) unsigned char lds_raw[];
    Frame F;
    F.lds = (LAS unsigned char*)lds_raw;
    F.G = gridDim.x; F.bx = blockIdx.x; F.wave = __builtin_amdgcn_readfirstlane(threadIdx.x >> 6);
#define REFRESH() do { unsigned o_ = ~0u; asm volatile("" : "+s"(o_)); const int l_ = __builtin_amdgcn_mbcnt_hi(o_, __builtin_amdgcn_mbcnt_lo(o_, 0u)); F.lane = l_; asm volatile("" : "+s"(F.wave), "+s"(F.G), "+s"(F.bx)); F.tid = F.wave * 64 + l_; \
        kaptr_t k_ = (kaptr_t)__builtin_amdgcn_kernarg_segment_ptr(); asm volatile("" : "+s"(k_)); F.ka = k_; \
        F.out = *(float* const __attribute__((address_space(4)))*)(k_ + 200); F.ws = *(unsigned char* const __attribute__((address_space(4)))*)(k_ + 208); \
        F.ctl = (unsigned*)(F.ws + WS_CTL); F.ctlf = (float*)(F.ws + WS_CTL); F.smallf = (float*)(F.ws + WS_SMALL); } while (0)
    REFRESH();
    for (int u = F.tid; u < (LDS_BYTES - LDSCTL_OFF) / 4; u += NTHR) ((LAS unsigned*)(F.lds + LDSCTL_OFF))[u] = 0u;
    __syncthreads();
    if (F.tid == 0) F.ctl[CW_XCCTAB + F.bx] = xb_xcc_id();
    { XcdBarrier b0 = xcd_barrier_post(F.ctl + CW_BAR, (volatile LAS unsigned*)(F.lds + MISC_OFF) + 8); (void)b0; }
#define GRID_BAR() do { XcdBarrier b_; b_.bar = F.ctl + CW_BAR; b_.x = xb_xcc_id(); b_.st = (volatile LAS unsigned*)(F.lds + MISC_OFF) + 8; xcd_barrier(b_); REFRESH(); } while (0)
#define RING (F.lds + RING_OFF)
#define CONDP (F.ctlf + CW_COND)

    p0_phase(F);
    GRID_BAR();
    p1_phase(F);
    GRID_BAR();
    {
        SchedPlain S{(const char*)(F.ws + WS_H0), (const char*)(F.ws + WS_WIN), (char*)(F.ws + WS_XM), DM, DM, DI, M / 256, DI / 256, F.G, F.bx};
        EpiGen<SchedPlain> E{S};
        pg8::gemm_phase<EpiGen<SchedPlain>, SchedPlain, true, true>(RING, F.wave, DM, DM, DM, S, E);
    }
    GRID_BAR();
    p3_phase(F);
    GRID_BAR();
    p3b_phase(F);
    if (F.G >= 128) { const int p = (int)F.bx - 8, np = F.G - 8; p0_cond(F, COND_A, COND_B, p, np); __syncthreads(); p0_convert(F, 2048, 3584, p < 0 ? -1 : p - (COND_B - COND_A), np - (COND_B - COND_A)); }
    else { p0_cond(F, COND_A, COND_B, F.bx, F.G); __syncthreads(); p0_convert(F, 2048, 3584, F.bx, F.G); }
    __syncthreads();
    GRID_BAR();
#define MLSTM_CORE(bsel) do { \
        char* KB = (char*)F.out; char* KWT = (char*)F.out + 32 * MiB; \
        const char* Wq = (const char*)(F.ws + WS_WQKV); const char* Wk = Wq + (size_t)NH * DH * DH * 2; const char* Wv = Wk + (size_t)NH * DH * DH * 2; \
        { \
            SchedQK S{(const char*)(F.ws + WS_XC), Wq, Wk, (char*)(F.ws + WS_AQ), KB, bsel, F.G, F.bx}; \
            EpiQK E{S, KWT, F.smallf + SW_WK, F.ctlf + CW_DN}; \
            pg8::gemm_phase<EpiQK, SchedQK, true, true>(RING, F.wave, DI, DH, DH, S, E); \
        } \
        { \
            SchedKV S{(const char*)(F.ws + WS_XM), Wv, (char*)(F.ws + WS_BC), bsel, F.G, F.bx}; \
            EpiGen<SchedKV> E{S}; \
            pg8::gemm_phase<EpiGen<SchedKV>, SchedKV, true, true>(RING, F.wave, DH, DI, DH, S, E); \
        } \
        GRID_BAR(); \
        { \
            SchedS S{(char*)(F.ws + WS_AQ), KB, F.smallf + SW_CS, F.ctlf + CW_DENI, bsel, F.G, F.bx}; \
            EpiGen<SchedS> E{S}; \
            pg8::gemm_phase<EpiGen<SchedS>, SchedS, false, true>(RING, F.wave, 768, DI, DH, S, E); \
        } \
        { \
            SchedDC S{(char*)(F.ws + WS_BC), KWT, F.G, F.bx}; \
            EpiGen<SchedDC> E{S}; \
            pg8::gemm_phase<EpiGen<SchedDC>, SchedDC, true, true>(RING, F.wave, 768, 256, 256, S, E); \
        } \
        GRID_BAR(); \
        p6_phase(F, bsel); \
        GRID_BAR(); \
        { \
            SchedH S{(const char*)(F.ws + WS_AQ), (const char*)(F.ws + WS_BC), (char*)(F.ws + WS_XM), F.smallf + SW_DENF, (float*)(F.ws + WS_HSTAT), bsel, F.G, F.bx}; \
            EpiGen<SchedH> E{S}; \
            pg8::gemm_phase<EpiGen<SchedH>, SchedH, false, true>(RING, F.wave, 768, 768, 768, S, E); \
        } \
        GRID_BAR(); \
    } while (0)
    MLSTM_CORE(0);
    MLSTM_CORE(1);
#undef MLSTM_CORE
    if (F.G >= 16 && (F.G & 15) == 0) { const int p8p = (int)((F.bx >> 4) * 8 + (F.bx & 7)); constexpr int P8_CUT = NE * 768 / 4;
        if ((F.bx >> 3) & 1) moe_weights_part(F, 0, WS_MOEW0, p8p, F.G / 2, P8_CUT, NE * 768); else moe_weights_part(F, 0, WS_MOEW0, p8p, F.G / 2, 0, P8_CUT); }
    else moe_weights_phase(F, 0, WS_MOEW0);
    __syncthreads();
    {
        SchedPlain S{(const char*)(F.ws + WS_H0), (const char*)(F.ws + WS_WIN) + (size_t)DI * DM * 2, (char*)(F.ws + WS_HHB), DM, DM, DI, M / 256, DI / 256, F.G, F.bx};
        EpiZ E{S, (const bf16*)(F.ws + WS_XM), (const bf16*)(F.ws + WS_XC), (float*)(F.ws + WS_HSTAT), KIN(F, I_AGN), KIN(F, I_ASKIP)};
        pg8::gemm_phase<EpiZ, SchedPlain, true, true>(RING, F.wave, DM, DM, DM, S, E);
    }
    GRID_BAR();
    {
        SchedPlain S{(const char*)(F.ws + WS_HHB), (const char*)(F.ws + WS_WOUT), (char*)(F.ws + WS_U0), DI, DI, DM, M / 256, DM / 256, F.G, F.bx};
        EpiGen<SchedPlain> E{S};
        pg8::gemm_phase<EpiGen<SchedPlain>, SchedPlain, false, true>(RING, F.wave, DI, DI, DI, S, E);
    }
    GRID_BAR();
    moe_route_phase(F, KIN(F, I_X), nullptr, 0, (const bf16*)(F.ws + WS_U0), (bf16*)(F.ws + WS_HMOE0), 0, 0, 0);
    GRID_BAR();
    {
        const int nb = moe_build_table(F, 0);
        SchedMoe S{(const char*)(F.ws + WS_HMOE0), (const char*)(F.ws + WS_MOEW0), (char*)F.out, (LAS const int*)(F.lds + LDS_TAB_OFF), (const int*)(F.smallf + SW_BT), 1, DM, DM, DFF, 128, 1024}; S.map(nb, F.G, F.bx, 0);
        EpiMoe1 E{S, nullptr, nullptr, false};
        pg8::gemm_phase<EpiMoe1, SchedMoe, true, true, true>(RING, F.wave, DM, DM, DM, S, E, (LAS int*)(F.lds + LDS_TAB_OFF + 2048));
        int maxc = 0, np = 0, p = -1;
        for (int x = 0; x < 8; ++x) { SchedMoe T = S; T.map(nb, F.G, x, 0); const int c0 = (T.nbx4 + T.Gx - 1) / T.Gx; maxc = c0 > maxc ? c0 : maxc; }
        for (int x = 0; x < 8; ++x) { SchedMoe T = S; T.map(nb, F.G, x, 0); int hv = T.nbx4 - (maxc - 1) * T.Gx; hv = hv < 0 ? 0 : (hv > T.Gx ? T.Gx : hv);
            if (x == S.x && S.j >= hv) p = np + (S.j - hv); np += T.Gx - hv; }
        __syncthreads();
        if (np >= 64) moe_weights_part(F, 1, WS_MOEW1, p, np); else moe_weights_part(F, 1, WS_MOEW1, F.bx, F.G);
    }
    GRID_BAR();
    {
        const int nb = moe_build_table(F, 0);
        SchedMoe S{(const char*)F.out, (const char*)(F.ws + WS_MOEW0) + (size_t)NE * 1024 * 1024 * 2, (char*)(F.ws + WS_YS0), (LAS const int*)(F.lds + LDS_TAB_OFF), nullptr, 0, DFF, DFF, DM, 256, 1024}; S.map(nb, F.G, F.bx, 0);
        EpiGen<SchedMoe> E{S};
        pg8::gemm_phase<EpiGen<SchedMoe>, SchedMoe, true, true>(RING, F.wave, DFF, DFF, DFF, S, E);
        int maxc = 0, np = 0, p = -1;
        for (int x = 0; x < 8; ++x) { SchedMoe T = S; T.map(nb, F.G, x, 0); const int c0 = (T.nbx4 + T.Gx - 1) / T.Gx; maxc = c0 > maxc ? c0 : maxc; }
        for (int x = 0; x < 8; ++x) { SchedMoe T = S; T.map(nb, F.G, x, 0); int hv = T.nbx4 - (maxc - 1) * T.Gx; hv = hv < 0 ? 0 : (hv > T.Gx ? T.Gx : hv);
            if (x == S.x && S.j >= hv) p = np + (S.j - hv); np += T.Gx - hv; }
        __syncthreads();
        if (np >= 200) { p0_cond(F, COND_B, 256, p, np); __syncthreads(); p0_convert(F, 4608, 6656, p < 0 ? -1 : p - (256 - COND_B), np - (256 - COND_B)); }
        else { p0_cond(F, COND_B, 256, F.bx, F.G); __syncthreads(); p0_convert(F, 4608, 6656, F.bx, F.G); }
        __syncthreads();
    }
    GRID_BAR();
    moe_combine_phase(F, (const bf16*)(F.ws + WS_HMOE0), (const bf16*)(F.ws + WS_YS0), nullptr, 0, 1, (bf16*)(F.ws + WS_H1), (bf16*)(F.ws + WS_HKV));
    GRID_BAR();
    {
        SchedQKV1 S{(const char*)(F.ws + WS_H1), (const char*)(F.ws + WS_HKV), (const char*)(F.ws + WS_WQ1), (const char*)(F.ws + WS_WKV), (char*)F.out, (char*)F.out + 32 * MiB, (char*)(F.ws + WS_VT1), F.ctlf + CW_KM, F.G, F.bx};
        EpiQKV1 E{S, F.ctlf + CW_KNP};
        pg8::gemm_phase<EpiQKV1, SchedQKV1, true, true>(RING, F.wave, DM, DM, DM, S, E);
    }
    GRID_BAR();
    moba_route_phase(F, 0);
    GRID_BAR();
    moba_attn_phase(F);
    GRID_BAR();
    moba_combine_phase(F);
    GRID_BAR();
    {
        SchedPlain S{(const char*)(F.ws + WS_OB), (const char*)(F.ws + WS_WO1), (char*)F.out, DM, DM, DM, M / 256, DM / 256, F.G, F.bx};
        EpiGen<SchedPlain> E{S};
        pg8::gemm_phase<EpiGen<SchedPlain>, SchedPlain, false, true>(RING, F.wave, DM, DM, DM, S, E);
    }
    GRID_BAR();
    moe_route_phase(F, nullptr, (const bf16*)(F.ws + WS_H1), mod_off(1, 0, 0), (const bf16*)F.out, (bf16*)(F.ws + WS_HMOE1), 1, 2, 1);
    GRID_BAR();
    {
        const int nb = moe_build_table(F, 1);
        SchedMoe S{(const char*)(F.ws + WS_HMOE1), (const char*)(F.ws + WS_MOEW1), (char*)(F.ws + WS_ACT1), (LAS const int*)(F.lds + LDS_TAB_OFF), (const int*)(F.smallf + SW_BT), 1, DM, DM, DFF, 128, 1024}; S.map(nb, F.G, F.bx, 0);
        EpiMoe1 E{S, F.ctl + CW_SIG, (LAS unsigned*)(F.lds + MISC_OFF) + 16, moe_group_same_xcd(F, S.x, S.Gx)};
        pg8::gemm_phase<EpiMoe1, SchedMoe, true, true, true>(RING, F.wave, DM, DM, DM, S, E, (LAS int*)(F.lds + LDS_TAB_OFF + 2048));
    }
    {
        const int nb = moe_build_table(F, 1);
        SchedMoe S{(const char*)(F.ws + WS_ACT1), (const char*)(F.ws + WS_MOEW1) + (size_t)NE * 1024 * 1024 * 2, (char*)(F.ws + WS_YS1), (LAS const int*)(F.lds + LDS_TAB_OFF), nullptr, 0, DFF, DFF, DM, 256, 1024}; S.map(nb, F.G, F.bx, 1);
        moe_wait_first(F, S, moe_group_same_xcd(F, S.x, S.Gx));
        EpiGen<SchedMoe> E{S};
        pg8::gemm_phase<EpiGen<SchedMoe>, SchedMoe, true, true>(RING, F.wave, DFF, DFF, DFF, S, E);
    }
    GRID_BAR();
    moe_combine_phase(F, (const bf16*)(F.ws + WS_HMOE1), (const bf16*)(F.ws + WS_YS1), F.out, 1, 3, nullptr, nullptr);
}

extern "C" void kernel_launch(void* const* d_in, const int* in_sizes, int n_in, void* d_out, int out_size, void* d_ws, size_t ws_size, hipStream_t stream) {
    static int grid = 0;
    if (grid == 0) {
        if (n_in != 25 || out_size != M * DM || ws_size < WS_END) { fprintf(stderr, "kernel_launch: unexpected shapes (n_in %d out %d ws %zu)\n", n_in, out_size, ws_size); grid = -1; return; }
        int dev = 0, cus = 0, per_cu = 0;
        if (hipGetDevice(&dev) != hipSuccess || hipDeviceGetAttribute(&cus, hipDeviceAttributeMultiprocessorCount, dev) != hipSuccess) { grid = -1; return; }
        if (hipFuncSetAttribute((const void*)mk_fwd, hipFuncAttributeMaxDynamicSharedMemorySize, LDS_BYTES) != hipSuccess) { fprintf(stderr, "kernel_launch: hipFuncSetAttribute failed\n"); grid = -1; return; }
        if (hipOccupancyMaxActiveBlocksPerMultiprocessor(&per_cu, (const void*)mk_fwd, NTHR, LDS_BYTES) != hipSuccess || per_cu < 1) { fprintf(stderr, "kernel_launch: occupancy query says %d blocks/CU\n", per_cu); (void)hipGetLastError(); grid = -1; return; }
        grid = cus;
    }
    if (grid < 0) return;
    (void)hipMemsetAsync((char*)d_ws + WS_CTL, 0, CTL_ZERO_BYTES, stream);
    Args a{};
    for (int i = 0; i < 25; ++i) a.in[i] = (const float*)d_in[i];
    a.out = (float*)d_out; a.ws = (unsigned char*)d_ws; a.ph_lo = 0; a.ph_hi = 0;
    hipLaunchKernelGGL(mk_fwd, dim3(grid), dim3(NTHR), LDS_BYTES, stream, a);
}
```

```cpp
#include <hip/hip_runtime.h>
#include <cstdio>
#include <cstdint>
#include <cmath>
namespace pg8 {
#define PG8_LAS __attribute__((address_space(3)))
#define PG8_LAS_T __attribute__((address_space(3)))
typedef unsigned short bf16_t;
typedef short bf16x8 __attribute__((ext_vector_type(8)));
typedef float f32x4 __attribute__((ext_vector_type(4)));
typedef float f32x2 __attribute__((ext_vector_type(2)));
typedef unsigned u32x4 __attribute__((ext_vector_type(4)));
typedef unsigned u32x2 __attribute__((ext_vector_type(2)));
constexpr int BM = 256, BK = 64, HALF = 128, HTB = HALF * BK * 2  , STAGE_BYTES = 8 * HTB;

__host__ __device__ __forceinline__ int lds_byte(int r, int c) { const int st = (r >> 4) * 2 + (c >> 5), rr = r & 15, cc = c & 31, ob = rr * 64 + cc * 2; return st * 1024 + (ob ^ (((ob >> 9) & 1) << 5)); }
__host__ __device__ __forceinline__ void stage_rc(int b, int& R, int& C) { const int st = b / 1024, sb = b % 1024, swz = sb ^ (((sb >> 9) & 1) << 5); R = (st >> 1) * 16 + swz / 64; C = (st & 1) * 32 + (swz % 64) / 2; }
__host__ __device__ __forceinline__ int perm32(int rho) { const int n = rho >> 4, i = rho & 15; return 8 * (i >> 2) + 4 * n + (i & 3); }

typedef __bf16 bf16x2_t __attribute__((ext_vector_type(2)));
__device__ __forceinline__ unsigned cvt_pk_bf16(float lo, float hi) { f32x2 v = {lo, hi}; bf16x2_t b = __builtin_convertvector(v, bf16x2_t); return __builtin_bit_cast(unsigned, b); }

template <class Epi, class Sched, bool ALIGN_EPI, bool SP2, bool GATHER = false>
__device__ __forceinline__ void gemm_phase(PG8_LAS unsigned char* lds, const int wid, const int lda, const int ldb, const int K, const Sched& S, const Epi& E, PG8_LAS int* tokTab = nullptr) {
    unsigned ones_ = ~0u; asm volatile("" : "+s"(ones_));
    const int lane = __builtin_amdgcn_mbcnt_hi(ones_, __builtin_amdgcn_mbcnt_lo(ones_, 0u));
    const int tid = wid * 64 + lane, wr = wid >> 2, wc = wid & 3, fr = lane & 15, fq = lane >> 4;
    const int nt = K / BK;
    unsigned voffA[2], voffA1[2], voffB[2]; int gR[2], gC[2];
#pragma unroll
    for (int i = 0; i < 2; ++i) { int R, C; stage_rc(tid * 16 + i * 8192, R, C); const int Rb = Epi::PERM ? ((R & ~31) + perm32(R & 31)) : R; gR[i] = R; gC[i] = C;
        voffA[i] = (unsigned)(R * lda + C) * 2u; voffA1[i] = voffA[i]; voffB[i] = (unsigned)(Rb * ldb + C) * 2u; }
    const size_t kstep = (size_t)(BK * 2);
    const size_t hstepA = GATHER ? (size_t)0 : (size_t)HALF * lda * 2, hstepB = (size_t)HALF * ldb * 2;
#define PG8_GOFF(slot) do { _Pragma("unroll") for (int _i = 0; _i < 2; ++_i) { \
        voffA[_i] = ((unsigned)tokTab[(slot) * 256 + gR[_i]] * (unsigned)lda + (unsigned)gC[_i]) * 2u; voffA1[_i] = ((unsigned)tokTab[(slot) * 256 + 128 + gR[_i]] * (unsigned)lda + (unsigned)gC[_i]) * 2u; } } while (0)
    const unsigned ldsw = (unsigned)wid * 1024u;
    const int aoff = lds_byte(wr * 64 + fr, fq * 8), boff = lds_byte(wc * 32 + fr, fq * 8);
#define PG8_SA(b, h) (((b) * 2 + (h)) * HTB)
#define PG8_SB(b, h) ((4 + (b) * 2 + (h)) * HTB)
#define PG8_STAGE(bufoff, gbase, voff) do { _Pragma("unroll") for (int _i = 0; _i < 2; ++_i) \
        __builtin_amdgcn_global_load_lds((const unsigned*)((const char*)(gbase) + (voff)[_i]), (PG8_LAS unsigned*)(lds + (bufoff) + ldsw + _i * 8192), 16, 0, 0); } while (0)
#define PG8_LDA(dst, b, h) do { _Pragma("unroll") for (int m = 0; m < 4; ++m) _Pragma("unroll") for (int k = 0; k < 2; ++k) dst[m][k] = *(const PG8_LAS bf16x8*)(lds + PG8_SA(b, h) + aoff + m * 2048 + k * 1024); } while (0)
#define PG8_LDB(dst, b, h) do { _Pragma("unroll") for (int n = 0; n < 2; ++n) _Pragma("unroll") for (int k = 0; k < 2; ++k) dst[n][k] = *(const PG8_LAS bf16x8*)(lds + PG8_SB(b, h) + boff + n * 2048 + k * 1024); } while (0)
#define PG8_MMA(ai, bj, At, Bt) do { __builtin_amdgcn_s_setprio(1); _Pragma("unroll") for (int m = 0; m < 4; ++m) _Pragma("unroll") for (int n = 0; n < 2; ++n) _Pragma("unroll") for (int k = 0; k < 2; ++k) \
        acc[ai][bj][m][n] = __builtin_amdgcn_mfma_f32_16x16x32_bf16(Bt[n][k], At[m][k], acc[ai][bj][m][n], 0, 0, 0); __builtin_amdgcn_s_setprio(0); } while (0)
#define PG8_WAIT_V(n) asm volatile("s_waitcnt vmcnt(" #n ")" ::: "memory")
#define PG8_WAIT_L(n) asm volatile("s_waitcnt lgkmcnt(" #n ")" ::: "memory")
#define PG8_BAR __builtin_amdgcn_s_barrier()
#define PG8_SCHED __builtin_amdgcn_sched_barrier(0)
    const char* cA; const char* cB; const char* nA; const char* nB; int ui = 0;
    if (!S.next(0, cA, cB)) return;
    if constexpr (GATHER) { S.load_tokens(0, tokTab, tid); asm volatile("s_waitcnt vmcnt(0) lgkmcnt(0)" ::: "memory"); __builtin_amdgcn_s_barrier(); PG8_GOFF(0); }
    f32x4 acc[2][2][4][2];
#pragma unroll
    for (int a = 0; a < 2; ++a)
#pragma unroll
        for (int b = 0; b < 2; ++b)
#pragma unroll
            for (int m = 0; m < 4; ++m)
#pragma unroll
                for (int n = 0; n < 2; ++n) acc[a][b][m][n] = (f32x4){0.f, 0.f, 0.f, 0.f};
    bf16x8 At[4][2], B0[2][2], B1[2][2];
    if constexpr (SP2) {
        PG8_STAGE(PG8_SB(0, 0), cB, voffB); PG8_STAGE(PG8_SB(0, 1), cB + hstepB, voffB); PG8_STAGE(PG8_SA(0, 0), cA, voffA); PG8_STAGE(PG8_SA(0, 1), cA + hstepA, voffA1);
        if (wr == 1) PG8_BAR;
        PG8_WAIT_V(2); PG8_BAR;
        PG8_STAGE(PG8_SB(1, 0), cB + kstep, voffB); PG8_STAGE(PG8_SA(1, 0), cA + kstep, voffA); PG8_STAGE(PG8_SB(1, 1), cB + hstepB + kstep, voffB);
        PG8_WAIT_V(6); PG8_BAR;
    } else {
        PG8_STAGE(PG8_SB(0, 0), cB, voffB); PG8_STAGE(PG8_SA(0, 0), cA, voffA); PG8_STAGE(PG8_SB(0, 1), cB + hstepB, voffB); PG8_STAGE(PG8_SA(0, 1), cA + hstepA, voffA1);
        if (wr == 1) PG8_BAR;
        PG8_WAIT_V(4); PG8_BAR;
        PG8_STAGE(PG8_SB(1, 0), cB + kstep, voffB); PG8_STAGE(PG8_SA(1, 0), cA + kstep, voffA); PG8_STAGE(PG8_SB(1, 1), cB + hstepB + kstep, voffB);
        PG8_WAIT_V(6); PG8_BAR;
    }
    for (;;) {
        const bool has_next = S.next(ui + 1, nA, nB);
        if (!has_next) { nA = cA; nB = cB; }
        if constexpr (GATHER) { if (has_next) S.load_tokens(ui + 1, tokTab + ((ui + 1) & 1) * 256, tid); }
        _Pragma("unroll 1") for (int t = 0; t < nt; t += 2) {
            const bool last = (t == nt - 2);
            const char* a1 = cA + (size_t)(t + 1) * kstep;
            const char* a2 = last ? nA : cA + (size_t)(t + 2) * kstep; const char* b2 = last ? nB : cB + (size_t)(t + 2) * kstep;
            const char* a3 = a2 + kstep; const char* b3 = b2 + kstep;
            if constexpr (SP2) {
            PG8_LDB(B0, 0, 0); PG8_LDB(B1, 0, 1); PG8_SCHED; PG8_LDA(At, 0, 0); PG8_STAGE(PG8_SA(1, 1), a1 + hstepA, voffA1);
            if constexpr (GATHER) { if (last && has_next) { PG8_SCHED; PG8_GOFF((ui + 1) & 1); } }
            PG8_WAIT_V(8); PG8_WAIT_L(0); PG8_BAR; PG8_MMA(0, 0, At, B0); PG8_MMA(0, 1, At, B1); PG8_BAR; PG8_SCHED;
            PG8_LDA(At, 0, 1); PG8_STAGE(PG8_SB(0, 0), b2, voffB); PG8_STAGE(PG8_SB(0, 1), b2 + hstepB, voffB); PG8_STAGE(PG8_SA(0, 0), a2, voffA);
            PG8_WAIT_V(8); PG8_WAIT_L(0); PG8_BAR; PG8_MMA(1, 0, At, B0); PG8_MMA(1, 1, At, B1); PG8_BAR; PG8_SCHED;
            PG8_LDB(B0, 1, 0); PG8_LDB(B1, 1, 1); PG8_SCHED; PG8_LDA(At, 1, 0); PG8_STAGE(PG8_SA(0, 1), a2 + hstepA, voffA1);
            PG8_WAIT_V(8); PG8_WAIT_L(0); PG8_BAR; PG8_MMA(0, 0, At, B0); PG8_MMA(0, 1, At, B1); PG8_BAR; PG8_SCHED;
            PG8_LDA(At, 1, 1); PG8_STAGE(PG8_SB(1, 0), b3, voffB); PG8_STAGE(PG8_SB(1, 1), b3 + hstepB, voffB); PG8_STAGE(PG8_SA(1, 0), a3, voffA);
            PG8_WAIT_V(8); PG8_WAIT_L(0); PG8_BAR; PG8_MMA(1, 0, At, B0); PG8_MMA(1, 1, At, B1); PG8_BAR; PG8_SCHED;
            } else {
            PG8_LDB(B0, 0, 0); PG8_SCHED; PG8_LDA(At, 0, 0); PG8_STAGE(PG8_SA(1, 1), a1 + hstepA, voffA1);
            PG8_WAIT_L(8); PG8_BAR; PG8_WAIT_L(0); PG8_MMA(0, 0, At, B0); PG8_BAR; PG8_SCHED;
            PG8_LDB(B1, 0, 1); PG8_STAGE(PG8_SB(0, 0), b2, voffB);
            PG8_BAR; PG8_WAIT_L(0); PG8_MMA(0, 1, At, B1); PG8_BAR;
            PG8_LDA(At, 0, 1); PG8_STAGE(PG8_SA(0, 0), a2, voffA);
            PG8_BAR; PG8_WAIT_L(0); PG8_MMA(1, 0, At, B0); PG8_BAR; PG8_SCHED;
            PG8_STAGE(PG8_SB(0, 1), b2 + hstepB, voffB);
            PG8_WAIT_V(6); PG8_BAR; PG8_MMA(1, 1, At, B1); PG8_BAR;
            PG8_LDB(B0, 1, 0); PG8_SCHED; PG8_LDA(At, 1, 0); PG8_STAGE(PG8_SA(0, 1), a2 + hstepA, voffA1);
            PG8_WAIT_L(8); PG8_BAR; PG8_WAIT_L(0); PG8_MMA(0, 0, At, B0); PG8_BAR; PG8_SCHED;
            PG8_LDB(B1, 1, 1); PG8_STAGE(PG8_SB(1, 0), b3, voffB);
            PG8_BAR; PG8_WAIT_L(0); PG8_MMA(0, 1, At, B1); PG8_BAR;
            PG8_LDA(At, 1, 1); PG8_STAGE(PG8_SA(1, 0), a3, voffA);
            PG8_BAR; PG8_WAIT_L(0); PG8_MMA(1, 0, At, B0); PG8_BAR; PG8_SCHED;
            PG8_STAGE(PG8_SB(1, 1), b3 + hstepB, voffB);
            PG8_WAIT_V(6); PG8_BAR; PG8_MMA(1, 1, At, B1); PG8_BAR;
            }
        }
        if constexpr (ALIGN_EPI) { if (wr == 0) PG8_BAR; }
        E(acc, ui, wr, wc, fr, fq);
        if (!has_next) break;
#pragma unroll
        for (int a = 0; a < 2; ++a)
#pragma unroll
            for (int b = 0; b < 2; ++b)
#pragma unroll
                for (int m = 0; m < 4; ++m)
#pragma unroll
                    for (int n = 0; n < 2; ++n) acc[a][b][m][n] = (f32x4){0.f, 0.f, 0.f, 0.f};
        cA = nA; cB = nB; ++ui;
        if constexpr (ALIGN_EPI) { if (wr == 1) PG8_BAR; }
    }
    PG8_WAIT_V(0);
    if constexpr (!ALIGN_EPI) { if (wr == 0) PG8_BAR; }
    PG8_BAR;
#undef PG8_GOFF
#undef PG8_SA
#undef PG8_SB
#undef PG8_STAGE
#undef PG8_LDA
#undef PG8_LDB
#undef PG8_MMA
#undef PG8_WAIT_V
#undef PG8_WAIT_L
#undef PG8_BAR
#undef PG8_SCHED
}
}
constexpr int NWAVES = 8, NTHR = 512;
constexpr int BATCH = 2, SEQ = 8192, DM = 1024, M = BATCH * SEQ;
constexpr int DI = 2048, NH = 4, DH = 512, LCH = 256, NCH = SEQ / LCH;
constexpr int AH = 16, HD = 64, MBLK = 256, NBLK = SEQ / MBLK;
constexpr int NE = 16, DFF = 512;
constexpr int NMOD = 2 * 6 * DM + 2 * DM;
constexpr float LN_EPS = 1e-5f;
constexpr float DN_ALPHA = 1.4142135623730951f;
constexpr float LOG2E = 1.4426950408889634f;

constexpr size_t MiB = 1u << 20;
constexpr size_t WS_CTL = 0, CTL_ZERO_BYTES = 256 * 1024;
constexpr size_t WS_SMALL = 4 * MiB;
constexpr size_t WS_WIN = 8 * MiB;
constexpr size_t WS_WQKV = 16 * MiB;
constexpr size_t WS_WOUT = 22 * MiB;
constexpr size_t WS_WKV = 26 * MiB;
constexpr size_t WS_WQ1 = 30 * MiB;
constexpr size_t WS_WO1 = 32 * MiB;
constexpr size_t WS_ARENA = 36 * MiB;
constexpr size_t WS_END = 364 * MiB;
constexpr size_t WS_XC = 36 * MiB;
constexpr size_t WS_H0 = 100 * MiB;
constexpr size_t WS_XM = 132 * MiB;
constexpr size_t WS_AQ = 196 * MiB;
constexpr size_t WS_BC = 244 * MiB;
constexpr size_t WS_HHB = 196 * MiB;
constexpr size_t WS_MOEW0 = 300 * MiB;
constexpr size_t WS_U0 = 36 * MiB;
constexpr size_t WS_X1 = 108 * MiB;
constexpr size_t WS_HMOE0 = 172 * MiB;
constexpr size_t WS_XG0 = 204 * MiB;
constexpr size_t WS_YS0 = 36 * MiB;
constexpr size_t WS_X2 = 300 * MiB;
constexpr size_t WS_H1 = 300 * MiB;
constexpr size_t WS_HKV = 332 * MiB;
constexpr size_t WS_VT1 = 36 * MiB;
constexpr size_t WS_MOEW1 = 108 * MiB;
constexpr size_t WS_LISTS = 68 * MiB;
constexpr size_t WS_PART = 156 * MiB;
constexpr size_t WS_LSE = 284 * MiB;
constexpr size_t WS_OB = 68 * MiB;
constexpr size_t WS_X3 = 156 * MiB;
constexpr size_t WS_HMOE1 = 220 * MiB;
constexpr size_t WS_XG1 = 252 * MiB;
constexpr size_t WS_ACT1 = 36 * MiB;
constexpr size_t WS_YS1 = 252 * MiB;

constexpr int CW_TMO = 0;
constexpr int CW_DBG = 8;
constexpr int CW_BAR = 4096;
constexpr int CW_MOECNT = 8192;
constexpr int CW_LCNT = 16384;
constexpr int CW_COND = 65536;
constexpr int CW_KNP = 98304;
constexpr int CW_KN = 130048;
constexpr int CW_KM = 131072;
constexpr int CW_DENI = 262144;
constexpr int CW_DN = 524288;
static_assert((CW_DN + 524288) * 4 <= (int)(4 * MiB), "CTL map");
constexpr size_t WS_HSTAT = 348 * MiB;
constexpr int SW_G = 0;
constexpr int SW_WK = 131072;
constexpr int SW_CS = 196608;
constexpr int SW_EA = 262144;
constexpr int SW_DENF = 327680;
constexpr int SW_DEC = 393216;
constexpr int SW_IDX = 397312;
constexpr int SW_WTS = 430080;
constexpr int SW_POS = 462848;
constexpr int BT_CAP = 16384;
constexpr int SW_BT = 495616;
static_assert((SW_BT + 16 * BT_CAP) * 4 <= (int)(4 * MiB), "SMALL map");

constexpr int RING_OFF = 0, RING_BYTES = 131072;
constexpr int LDSCTL_OFF = RING_BYTES, MISC_OFF = LDSCTL_OFF + 320;
constexpr int LDS_BYTES = 147456;

#define GAS __attribute__((address_space(1)))
#define LAS __attribute__((address_space(3)))
typedef unsigned short bf16;
typedef unsigned v4u __attribute__((ext_vector_type(4)));
typedef unsigned v2u __attribute__((ext_vector_type(2)));
typedef float f32x4 __attribute__((ext_vector_type(4)));
typedef float f32x16 __attribute__((ext_vector_type(16)));
typedef short bf16x8 __attribute__((ext_vector_type(8)));
typedef GAS unsigned gu32;
#define RLX_AGENT __ATOMIC_RELAXED, __HIP_MEMORY_SCOPE_AGENT
#define LDS_WAIT() asm volatile("s_waitcnt lgkmcnt(0)" ::: "memory")
#define VM_WAIT() asm volatile("s_waitcnt vmcnt(0)" ::: "memory")
__device__ __forceinline__ unsigned f2bf(float f) { unsigned u = __builtin_bit_cast(unsigned, f); return (u + 0x7fffu + ((u >> 16) & 1u)) >> 16; }
__device__ __forceinline__ unsigned pk2(float lo, float hi) { return f2bf(lo) | (f2bf(hi) << 16); }
__device__ __forceinline__ float bf2f(unsigned short h) { return __builtin_bit_cast(float, (unsigned)h << 16); }
__device__ __forceinline__ float bflo(unsigned w) { return __builtin_bit_cast(float, w << 16); }
__device__ __forceinline__ float bfhi(unsigned w) { return __builtin_bit_cast(float, w & 0xffff0000u); }
__device__ __forceinline__ float silu_f(float v) { return v * __builtin_amdgcn_rcpf(1.f + __builtin_amdgcn_exp2f(v * -1.44269504f)); }
__device__ __forceinline__ float wave_sum(float v) {
#pragma unroll
    for (int o = 1; o < 64; o <<= 1) v += __shfl_xor(v, o);
    return v;
}
template <int CTRL, int ROWMASK> __device__ __forceinline__ float dpp_add(float v) {
    const int t = __builtin_amdgcn_update_dpp(0, __builtin_bit_cast(int, v), CTRL, ROWMASK, 0xF, false);
    return v + __builtin_bit_cast(float, t);
}
template <int CTRL, int ROWMASK> __device__ __forceinline__ float dpp_add(float keep, float send) {
    const int t = __builtin_amdgcn_update_dpp(0, __builtin_bit_cast(int, send), CTRL, ROWMASK, 0xF, false);
    return keep + __builtin_bit_cast(float, t);
}
__device__ __forceinline__ float xsum32(float v) { auto r = __builtin_amdgcn_permlane32_swap(__float_as_uint(v), __float_as_uint(v), false, false); return __uint_as_float(r[0]) + __uint_as_float(r[1]); }
__device__ __forceinline__ float xsum16(float v) { auto r = __builtin_amdgcn_permlane16_swap(__float_as_uint(v), __float_as_uint(v), false, false); return __uint_as_float(r[0]) + __uint_as_float(r[1]); }
__device__ __forceinline__ float rowsum16(float v) { v = dpp_add<0xB1, 0xF>(v); v = dpp_add<0x4E, 0xF>(v); v = dpp_add<0x141, 0xF>(v); return dpp_add<0x140, 0xF>(v); }
template <int CTRL> __device__ __forceinline__ float dpp_max(float v) { const int t = __builtin_amdgcn_update_dpp(__builtin_bit_cast(int, v), __builtin_bit_cast(int, v), CTRL, 0xF, 0xF, false); return fmaxf(v, __builtin_bit_cast(float, t)); }
__device__ __forceinline__ float rowmax16(float v) { v = dpp_max<0xB1>(v); v = dpp_max<0x4E>(v); v = dpp_max<0x141>(v); return dpp_max<0x140>(v); }
__device__ __forceinline__ float wave_sum_dpp(float v) {
    v = dpp_add<0xB1, 0xF>(v);
    v = dpp_add<0x4E, 0xF>(v);
    v = dpp_add<0x141, 0xF>(v);
    v = dpp_add<0x140, 0xF>(v);
    v = dpp_add<0x142, 0xA>(v);
    v = dpp_add<0x143, 0xC>(v);
    return __builtin_bit_cast(float, __builtin_amdgcn_readlane(__builtin_bit_cast(int, v), 63));
}

#define XB_TMO      128
#define XB_XCNT(j)  (256  + 64 * (j))
#define XB_XSUB(j)  (1280 + 64 * (j))
#define XB_XGEN(j)  (2304 + 64 * (j))
#define XB_TOP      3328
#define XB_TOPGEN   3392
#define XCD_BAR_WORDS 3456
#define XB_SPIN_CAP (1u << 22)

__device__ __forceinline__ unsigned xb_ld(unsigned* p)              { return __hip_atomic_load(p, __ATOMIC_RELAXED, __HIP_MEMORY_SCOPE_AGENT); }
__device__ __forceinline__ unsigned xb_add(unsigned* p, unsigned v) { return __hip_atomic_fetch_add(p, v, __ATOMIC_RELAXED, __HIP_MEMORY_SCOPE_AGENT); }
__device__ __forceinline__ unsigned xb_xcc_id() { return (unsigned)__builtin_amdgcn_s_getreg((3 << 11) | 20) & 0xFu; }
#define XB_SPIN(cond, bar) do { unsigned _sp = 0; while (cond) { __builtin_amdgcn_s_sleep(1); \
    if ((++_sp & 255u) == 0u) { if (xb_ld(&(bar)[XB_TMO])) break; if (_sp > XB_SPIN_CAP) { atomicAdd(&(bar)[XB_TMO], 1u); break; } } } } while (0)

struct XcdBarrier { unsigned* bar; unsigned x; volatile LAS unsigned* st; };

__device__ __forceinline__ XcdBarrier xcd_barrier_post(unsigned* bar, volatile LAS unsigned* st) {
    XcdBarrier b; b.bar = bar; b.x = xb_xcc_id(); b.st = st;
    if (threadIdx.x == 0) (void)xb_add(&bar[XB_XCNT(b.x)], 1u);
    return b;
}
__device__ __forceinline__ void xcd_barrier_complete(unsigned* bar, unsigned x, unsigned& nloc, unsigned& nx) {
    const unsigned G = gridDim.x * gridDim.y * gridDim.z;
    unsigned sum, cnt, mine, sp = 0u;
    for (;;) {
        sum = 0u; cnt = 0u; mine = 0u;
#pragma unroll
        for (unsigned j = 0; j < 16; ++j) { const unsigned c = xb_ld(&bar[XB_XCNT(j)]); sum += c; cnt += (c > 0u) ? 1u : 0u; mine = (j == x) ? c : mine; }
        if (sum == G) break;
        __builtin_amdgcn_s_sleep(1);
        if ((++sp & 255u) == 0u) { if (xb_ld(&bar[XB_TMO])) break; if (sp > XB_SPIN_CAP) { atomicAdd(&bar[XB_TMO], 1u); break; } }
    }
    nloc = mine > 0u ? mine : 1u; nx = cnt > 0u ? cnt : 1u;
}
__device__ __forceinline__ void xcd_barrier(const XcdBarrier& b) {
    asm volatile("s_waitcnt vmcnt(0)" ::: "memory");
    __syncthreads();
    if (threadIdx.x == 0) {
        unsigned* bar = b.bar;
        __builtin_amdgcn_s_waitcnt(0);
        unsigned nloc = b.st[0], nx = b.st[1];
        if (nloc == 0u) { xcd_barrier_complete(bar, b.x, nloc, nx); b.st[0] = nloc; b.st[1] = nx; }
        const unsigned old = xb_add(&bar[XB_XSUB(b.x)], 1u);
        const unsigned gen = old / nloc;
        if (old + 1u == (gen + 1u) * nloc) {
            __builtin_amdgcn_fence(__ATOMIC_RELEASE, "agent");
            asm volatile("s_waitcnt vmcnt(0)" ::: "memory");
            const unsigned og = xb_add(&bar[XB_TOP], 1u);
            const unsigned tg = og / nx;
            if (og + 1u == (tg + 1u) * nx) xb_add(&bar[XB_TOPGEN], 1u);
            else XB_SPIN(xb_ld(&bar[XB_TOPGEN]) == tg, bar);
            __builtin_amdgcn_fence(__ATOMIC_ACQUIRE, "agent");
            xb_add(&bar[XB_XGEN(b.x)], 1u);
            asm volatile("s_waitcnt vmcnt(0)" ::: "memory");
        } else {
            XB_SPIN(xb_ld(&bar[XB_XGEN(b.x)]) == gen, bar);
            __builtin_amdgcn_fence(__ATOMIC_ACQUIRE, "agent");
            asm volatile("s_waitcnt vmcnt(0)" ::: "memory");
        }
    }
    __syncthreads();
}
struct Args {
    const float* in[25];
    float* out; unsigned char* ws;
    int ph_lo, ph_hi;
};
enum { I_X = 0, I_C, I_WADA, I_BADA, I_LNG, I_LNB, I_AWIN, I_ACONVW, I_ACONVB, I_AWQ, I_AWK, I_AWV, I_AWIF, I_ABIF, I_AGN, I_ASKIP, I_AWOUT,
       I_BWKV, I_BWQ, I_BWO, I_MWR, I_MBR, I_MWG, I_MWU, I_MWD };

typedef const char __attribute__((address_space(4)))* kaptr_t;
struct Frame {
    LAS unsigned char* lds;
    int tid, lane, wave, G, bx;
    kaptr_t ka;
    unsigned char* ws; float* out;
    unsigned* ctl; float* ctlf; float* smallf;
};
#define KIN(F, i) (*(const float* const __attribute__((address_space(4)))*)((F).ka + 8 * (i)))
__device__ __forceinline__ int mod_off(int layer, int sub, int which) { return ((layer * 2 + sub) * 3 + which) * DM; }

__device__ __forceinline__ void tile_map(int L, int nM, int nN, int& pm, int& pn) {
    const int nwg = nM * nN; int wgid = L;
    { const int q = nwg / 8, r = nwg % 8, xcd = wgid % 8, off = wgid / 8; wgid = (xcd < r ? xcd * (q + 1) : r * (q + 1) + (xcd - r) * q) + off; }
    const int nig = 8 * nN, gid = wgid / nig, fm = gid * 8, gsz = (nM - fm) < 8 ? (nM - fm) : 8;
    pm = fm + ((wgid % nig) % gsz); pn = (wgid % nig) / gsz;
}

__device__ __forceinline__ int xremap(int L, int n) { const int q = n / 8, r = n % 8, x = L % 8, off = L / 8; return (x < r ? x * (q + 1) : r * (q + 1) + (x - r) * q) + off; }

struct EU { char* o; int ldc; const float* cs; const float* rw; float* rs; float* rs2; int rstride; int rslot; int causal; float* csum; };
template <class Sched> struct EpiGen {
    static constexpr bool PERM = true;
    Sched S;
    __device__ __forceinline__ void operator()(const pg8::f32x4 (&acc)[2][2][4][2], int ui, int wr, int wc, int fr, int fq) const {
        EU e = {}; S.info(ui, e);
        asm volatile("" : "+s"(e.ldc));
        bf16* base = (bf16*)e.o;
        const int colb = wc * 32 + 8 * fq;
        f32x4 cs[2][2];
#pragma unroll
        for (int bj = 0; bj < 2; ++bj)
#pragma unroll
            for (int n = 0; n < 2; ++n) cs[bj][n] = e.cs ? *(const f32x4*)(e.cs + bj * 128 + colb + 4 * n) : (f32x4){1.f, 1.f, 1.f, 1.f};
        float rwa[2][4];
#pragma unroll
        for (int ai = 0; ai < 2; ++ai)
#pragma unroll
            for (int m = 0; m < 4; ++m) rwa[ai][m] = e.rw ? e.rw[ai * 128 + wr * 64 + m * 16 + fr] : 1.f;
#pragma unroll
        for (int ai = 0; ai < 2; ++ai)
#pragma unroll
            for (int m = 0; m < 4; ++m) {
                const int row = ai * 128 + wr * 64 + m * 16 + fr;
                const float rwv = rwa[ai][m];
                float s1 = 0.f, s2 = 0.f;
#pragma unroll
                for (int bj = 0; bj < 2; ++bj) {
                    f32x4 v0 = acc[ai][bj][m][0] * cs[bj][0] * rwv, v1 = acc[ai][bj][m][1] * cs[bj][1] * rwv;
                    if (e.causal) { const int c0 = bj * 128 + colb;
#pragma unroll
                        for (int j = 0; j < 4; ++j) { if (c0 + j > row) v0[j] = 0.f; if (c0 + 4 + j > row) v1[j] = 0.f; } }
                    s1 += (v0[0] + v0[1]) + (v0[2] + v0[3]) + (v1[0] + v1[1]) + (v1[2] + v1[3]);
                    s2 += (v0[0] * v0[0] + v0[1] * v0[1]) + (v0[2] * v0[2] + v0[3] * v0[3]) + (v1[0] * v1[0] + v1[1] * v1[1]) + (v1[2] * v1[2] + v1[3] * v1[3]);
                    v4u w; w.x = pg8::cvt_pk_bf16(v0[0], v0[1]); w.y = pg8::cvt_pk_bf16(v0[2], v0[3]); w.z = pg8::cvt_pk_bf16(v1[0], v1[1]); w.w = pg8::cvt_pk_bf16(v1[2], v1[3]);
                    *(v4u*)(base + (unsigned)(row * e.ldc + bj * 128 + colb)) = w;
                }
                if (e.rs) { s1 = xsum32(xsum16(s1)); if (fq == 0) e.rs[(size_t)row * e.rstride + wc * e.rslot] = s1; }
                if (e.rs2) { s2 = xsum32(xsum16(s2)); if (fq == 0) e.rs2[(size_t)row * e.rstride + wc * e.rslot] = s2; }
            }
        if (e.csum) {
            unsigned cbl = (unsigned)(colb * 2 + wr); asm volatile("" : "+v"(cbl));
#pragma unroll
            for (int bj = 0; bj < 2; ++bj)
#pragma unroll
                for (int n = 0; n < 2; ++n) { f32x4 c4 = (f32x4){0.f, 0.f, 0.f, 0.f};
#pragma unroll
                    for (int ai = 0; ai < 2; ++ai)
#pragma unroll
                        for (int m = 0; m < 4; ++m) c4 += acc[ai][bj][m][n];
#pragma unroll
                    for (int j = 0; j < 4; ++j) { float v = rowsum16(c4[j]);
                        if (fr == 0) e.csum[cbl + (unsigned)((bj * 128 + 4 * n + j) * 2)] = v; } }
        }
    }
};

__device__ __forceinline__ void transpose_item(const float* W, int ldw, bf16* WT, int ldt, int k0, int n0, int orow0, float scale, LAS float* scr, int lane) {
#pragma unroll 8
    for (int i = 0; i < 32; ++i) { const int kk = 2 * i + (lane >> 5); scr[kk * 33 + (lane & 31)] = W[(size_t)(k0 + kk) * ldw + n0 + (lane & 31)]; }
    LDS_WAIT(); asm volatile("" ::: "memory");
    const int c = lane & 7;
#pragma unroll
    for (int j = 0; j < 4; ++j) { const int n = (lane >> 3) + 8 * j; const LAS float* s = scr + (8 * c) * 33 + n;
        v4u o; o.x = pk2(s[0 * 33] * scale, s[1 * 33] * scale); o.y = pk2(s[2 * 33] * scale, s[3 * 33] * scale); o.z = pk2(s[4 * 33] * scale, s[5 * 33] * scale); o.w = pk2(s[6 * 33] * scale, s[7 * 33] * scale);
        *(GAS v4u*)(WT + (size_t)(orow0 + n) * ldt + k0 + 8 * c) = o; }
    LDS_WAIT(); asm volatile("" ::: "memory");
}
__device__ __forceinline__ void transpose_plain(const float* W, int K, int N, bf16* WT, float scale, int item, LAS float* scr, int lane) {
    const int nblk = N / 32, kb = item / nblk, nb = item % nblk;
    transpose_item(W, N, WT, K, 64 * kb, 32 * nb, 32 * nb, scale, scr, lane);
}
__device__ __forceinline__ void p0_convert(Frame& F, int lo, int hi, int p, int np) {
    if (p < 0) return;
    LAS float* scr = (LAS float*)(F.lds + RING_OFF + F.wave * 8448);
    const int gw = p * NWAVES + F.wave, NGW = np * NWAVES;
    bf16* WinT = (bf16*)(F.ws + WS_WIN); bf16* Wqkv = (bf16*)(F.ws + WS_WQKV); bf16* WoutT = (bf16*)(F.ws + WS_WOUT);
    bf16* WkvT = (bf16*)(F.ws + WS_WKV); bf16* Wq1T = (bf16*)(F.ws + WS_WQ1); bf16* Wo1T = (bf16*)(F.ws + WS_WO1);
    constexpr int I0 = 2048, I1 = 1536, I2 = 1024, I3 = 1024, I4 = 512;
    for (int it = lo + gw; it < hi; it += NGW) {
        int r = it;
        if (r < I0) { transpose_plain(KIN(F, I_AWIN), DM, 2 * DI, WinT, 1.f, r, scr, F.lane); continue; } r -= I0;
        if (r < I1) { const int mat = r / 512, hh = (r % 512) / 128, item = r % 128;
            const float* W = KIN(F, I_AWQ + mat) + (size_t)hh * DH * DH; bf16* WT = Wqkv + ((size_t)mat * NH + hh) * DH * DH;
            transpose_plain(W, DH, DH, WT, mat == 1 ? 0.044194173824159216f : 1.f, item, scr, F.lane); continue; } r -= I1;
        if (r < I2) { transpose_plain(KIN(F, I_AWOUT), DI, DM, WoutT, 1.f, r, scr, F.lane); continue; } r -= I2;
        if (r < I3) { transpose_plain(KIN(F, I_BWKV), DM, 2 * DM, WkvT, 1.f, r, scr, F.lane); continue; } r -= I3;
        if (r < I4) { transpose_plain(KIN(F, I_BWQ), DM, DM, Wq1T, 0.125f * LOG2E, r, scr, F.lane); continue; } r -= I4;
        transpose_plain(KIN(F, I_BWO), DM, DM, Wo1T, 1.f, r, scr, F.lane);
    }
}
__device__ __forceinline__ void p0_cond(Frame& F, int lo, int hi, int p, int np) {
    if (p < 0 || lo + p >= hi) return;
    LAS float* sc = (LAS float*)(F.lds + RING_OFF);
    LAS float* part = sc + 2 * DM;
    const float* c = KIN(F, I_C); const float* wa = KIN(F, I_WADA); const float* ba = KIN(F, I_BADA);
    float* cond = F.ctlf + CW_COND;
    for (int i = F.tid; i < 2 * DM; i += NTHR) sc[i] = silu_f(c[i]);
    __syncthreads();
    for (int item = lo + p; item < hi; item += np) {
        if (F.tid < 448) {
            const int g = F.tid % 14, ks = F.tid / 14; const int n = item * 56 + g * 4;
            f32x4 a0 = (f32x4){0.f, 0.f, 0.f, 0.f}, a1 = a0;
#pragma unroll 8
            for (int r = 0; r < 32; ++r) { const int kk = ks * 32 + r; const f32x4 w = *(const f32x4*)(wa + (size_t)kk * NMOD + n);
                a0 += w * sc[kk]; a1 += w * sc[DM + kk]; }
#pragma unroll
            for (int j = 0; j < 4; ++j) { part[(ks * 2 + 0) * 56 + g * 4 + j] = a0[j]; part[(ks * 2 + 1) * 56 + g * 4 + j] = a1[j]; }
        }
        __syncthreads();
        if (F.tid < 112) { const int b = F.tid / 56, col = F.tid % 56; float s = ba[item * 56 + col];
            for (int ks = 0; ks < 32; ++ks) s += part[(ks * 2 + b) * 56 + col];
            cond[b * NMOD + item * 56 + col] = s; }
        __syncthreads();
    }
}
constexpr int COND_A = 55, COND_B = 110;
__device__ __forceinline__ void p0_phase(Frame& F) {
    p0_cond(F, 0, COND_A, F.bx, F.G);
    __syncthreads();
    p0_convert(F, 0, 2048, F.bx, F.G);
    p0_convert(F, 3584, 4608, F.bx, F.G);
}
__device__ __forceinline__ void moe_weights_phase(Frame& F, int layer, size_t ws_off) {
    LAS float* scr = (LAS float*)(F.lds + RING_OFF + F.wave * 8448);
    const int gw = F.bx * NWAVES + F.wave, NGW = F.G * NWAVES;
    bf16* W1T = (bf16*)(F.ws + ws_off); bf16* W2T = W1T + (size_t)NE * 1024 * 1024;
    const float* wg = KIN(F, I_MWG) + (size_t)layer * NE * DM * DFF; const float* wu = KIN(F, I_MWU) + (size_t)layer * NE * DM * DFF; const float* wd = KIN(F, I_MWD) + (size_t)layer * NE * DFF * DM;
    for (int it = gw; it < NE * 768; it += NGW) {
        const int e = it / 768, r = it % 768;
        if (r < 512) { const int up = r >> 8, item = r & 255; const int kb = item / 16, nb = item % 16, n0 = 32 * nb;
            const float* W = (up ? wu : wg) + (size_t)e * DM * DFF;
            transpose_item(W, DFF, W1T + (size_t)e * 1024 * 1024, 1024, 64 * kb, n0, (n0 >> 7) * 256 + (n0 & 127) + up * 128, 1.f, scr, F.lane);
        } else { const int item = r - 512; const int kb = item / 32, nb = item % 32;
            transpose_item(wd + (size_t)e * DFF * DM, DM, W2T + (size_t)e * 1024 * 512, 512, 64 * kb, 32 * nb, 32 * nb, 1.f, scr, F.lane); }
    }
}

__device__ __forceinline__ void moe_weights_part(Frame& F, int layer, size_t ws_off, int p, int np, int lo = 0, int hi = NE * 768) {
    if (p < 0) return;
    LAS float* scr = (LAS float*)(F.lds + RING_OFF + F.wave * 8448);
    const int gw = p * NWAVES + F.wave, NGW = np * NWAVES;
    bf16* W1T = (bf16*)(F.ws + ws_off); bf16* W2T = W1T + (size_t)NE * 1024 * 1024;
    const float* wg = KIN(F, I_MWG) + (size_t)layer * NE * DM * DFF; const float* wu = KIN(F, I_MWU) + (size_t)layer * NE * DM * DFF; const float* wd = KIN(F, I_MWD) + (size_t)layer * NE * DFF * DM;
    for (int it = lo + gw; it < hi; it += NGW) {
        const int e = it / 768, r = it % 768;
        if (r < 512) { const int up = r >> 8, item = r & 255; const int kb = item / 16, nb = item % 16, n0 = 32 * nb;
            const float* W = (up ? wu : wg) + (size_t)e * DM * DFF;
            transpose_item(W, DFF, W1T + (size_t)e * 1024 * 1024, 1024, 64 * kb, n0, (n0 >> 7) * 256 + (n0 & 127) + up * 128, 1.f, scr, F.lane);
        } else { const int item = r - 512; const int kb = item / 32, nb = item % 32;
            transpose_item(wd + (size_t)e * DFF * DM, DM, W2T + (size_t)e * 1024 * 512, 512, 64 * kb, 32 * nb, 32 * nb, 1.f, scr, F.lane); }
    }
}

__device__ __forceinline__ void p1_phase(Frame& F) {
    const float* x = KIN(F, I_X); const float* cond = F.ctlf + CW_COND; bf16* H0 = (bf16*)(F.ws + WS_H0);
    const int gw = F.bx * NWAVES + F.wave, NGW = F.G * NWAVES;
    for (int mp = gw; mp < M / 2; mp += NGW) {
        const int m0 = mp * 2, b = m0 / SEQ; const float* cb = cond + b * NMOD;
        f32x4 v[2][4];
#pragma unroll
        for (int q = 0; q < 2; ++q)
#pragma unroll
            for (int j = 0; j < 4; ++j) v[q][j] = *((const GAS f32x4*)(x + (size_t)(m0 + q) * DM) + F.lane + 64 * j);
#pragma unroll
        for (int q = 0; q < 2; ++q) { GAS v2u* o8 = (GAS v2u*)(H0 + (size_t)(m0 + q) * DM) + F.lane;
#pragma unroll
            for (int j = 0; j < 4; ++j) { const int col = 4 * F.lane + 256 * j;
                const f32x4 sh = *(const f32x4*)(cb + mod_off(0, 0, 0) + col), sc = *(const f32x4*)(cb + mod_off(0, 0, 1) + col);
                const f32x4 h = v[q][j] * (sc + 1.f) + sh; v2u w; w.x = pk2(h[0], h[1]); w.y = pk2(h[2], h[3]); o8[64 * j] = w; } }
    }
}

__device__ __forceinline__ float logsigmoid_f(float v) { return fminf(v, 0.f) - log1pf(__expf(-fabsf(v))); }
__device__ __forceinline__ void p3_phase(Frame& F) {
    const bf16* XM = (const bf16*)(F.ws + WS_XM); bf16* XC = (bf16*)(F.ws + WS_XC); float* Gt = F.smallf + SW_G;
    const float* cw = KIN(F, I_ACONVW); const float* cb = KIN(F, I_ACONVB); const float* wif = KIN(F, I_AWIF); const float* bif = KIN(F, I_ABIF);
    LAS float* scr = (LAS float*)(F.lds + RING_OFF + F.wave * 16384);
    const int gw = F.bx * NWAVES + F.wave, NGW = F.G * NWAVES, lane = F.lane;
    for (int run = gw; run < M / 8; run += NGW) {
        const int t0 = run * 8, tl0 = t0 % SEQ;
        float gacc[8][8];
#pragma unroll
        for (int a = 0; a < 8; ++a)
#pragma unroll
            for (int g = 0; g < 8; ++g) gacc[a][g] = 0.f;
#pragma unroll 1
        for (int j = 0; j < 8; ++j) {
            const int ch0 = j * 256 + lane * 4;
            f32x4 w0 = *(const f32x4*)(cw + 0 * DI + ch0), w1 = *(const f32x4*)(cw + 1 * DI + ch0), w2 = *(const f32x4*)(cw + 2 * DI + ch0), w3 = *(const f32x4*)(cw + 3 * DI + ch0);
            const f32x4 bb = *(const f32x4*)(cb + ch0);
            f32x4 wf[4][2];
#pragma unroll
            for (int c = 0; c < 4; ++c) { wf[c][0] = *(const f32x4*)(wif + (size_t)(ch0 + c) * 8); wf[c][1] = *(const f32x4*)(wif + (size_t)(ch0 + c) * 8 + 4); }
            f32x4 xa, xb, xc_;
            {
                v2u r; const f32x4 z = (f32x4){0.f, 0.f, 0.f, 0.f};
                if (tl0 >= 3) { r = *(const v2u*)(XM + (size_t)(t0 - 3) * DI + ch0); xa = (f32x4){bflo(r.x), bfhi(r.x), bflo(r.y), bfhi(r.y)}; } else xa = z;
                if (tl0 >= 2) { r = *(const v2u*)(XM + (size_t)(t0 - 2) * DI + ch0); xb = (f32x4){bflo(r.x), bfhi(r.x), bflo(r.y), bfhi(r.y)}; } else xb = z;
                if (tl0 >= 1) { r = *(const v2u*)(XM + (size_t)(t0 - 1) * DI + ch0); xc_ = (f32x4){bflo(r.x), bfhi(r.x), bflo(r.y), bfhi(r.y)}; } else xc_ = z;
            }
#pragma unroll
            for (int tt = 0; tt < 8; ++tt) {
                const v2u r = *(const v2u*)(XM + (size_t)(t0 + tt) * DI + ch0);
                const f32x4 xd = (f32x4){bflo(r.x), bfhi(r.x), bflo(r.y), bfhi(r.y)};
                f32x4 y = bb + w0 * xa + w1 * xb + w2 * xc_ + w3 * xd;
                f32x4 s; s[0] = silu_f(y[0]); s[1] = silu_f(y[1]); s[2] = silu_f(y[2]); s[3] = silu_f(y[3]);
                v2u o; o.x = pk2(s[0], s[1]); o.y = pk2(s[2], s[3]);
                *(v2u*)(XC + (size_t)(t0 + tt) * DI + ch0) = o;
#pragma unroll
                for (int c = 0; c < 4; ++c) {
#pragma unroll
                    for (int g = 0; g < 4; ++g) { gacc[tt][g] += s[c] * wf[c][0][g]; gacc[tt][4 + g] += s[c] * wf[c][1][g]; }
                }
                xa = xb; xb = xc_; xc_ = xd;
            }
        }
#pragma unroll
        for (int tt = 0; tt < 8; ++tt)
#pragma unroll
            for (int g = 0; g < 8; ++g) { const int v = tt * 8 + g; scr[v * 64 + (lane ^ v)] = gacc[tt][g]; }
        LDS_WAIT(); asm volatile("" ::: "memory");
        float tot = 0.f;
#pragma unroll 16
        for (int l = 0; l < 64; ++l) tot += scr[lane * 64 + (l ^ lane)];
        LDS_WAIT(); asm volatile("" ::: "memory");
        const int tt = lane >> 3, g = lane & 7;
        float v = tot + bif[g];
        if (g >= 4) v = logsigmoid_f(v);
        Gt[(size_t)(t0 + tt) * 8 + g] = v;
    }
}

__device__ __forceinline__ void p3b_phase(Frame& F) {
    const float* Gt = F.smallf + SW_G;
    LAS float* lbl = (LAS float*)(F.lds + RING_OFF);
    for (int item = F.bx; item < 8; item += F.G) {
        const int b = item >> 2, h = item & 3, tid = F.tid, lane = F.lane;
        const int tb = tid * 16;
        float fi[16], bb[16];
        float run = 0.f;
#pragma unroll
        for (int s = 0; s < 16; ++s) { const size_t gi = ((size_t)(b * SEQ + tb + s)) * 8; fi[s] = Gt[gi + h]; run += Gt[gi + 4 + h]; bb[s] = run; }
        const float total = run;
        float incl = total;
#pragma unroll
        for (int o = 1; o < 16; o <<= 1) { const float v = __shfl_up(incl, o, 16); if ((lane & 15) >= o) incl += v; }
        const float excl = incl - total;
        const float blast = __shfl(incl, (lane & ~15) + 15);
        float gl = -INFINITY;
#pragma unroll
        for (int s = 0; s < 16; ++s) { bb[s] += excl; gl = fmaxf(gl, blast - bb[s] + fi[s]); }
#pragma unroll
        for (int o = 1; o < 16; o <<= 1) gl = fmaxf(gl, __shfl_xor(gl, o));
        const int c = tid >> 4;
        __syncthreads();
        if ((lane & 15) == 0) { lbl[c] = blast; lbl[32 + c] = gl; }
        __syncthreads();
        if (tid == 0) { float m = 0.f; for (int cc = 0; cc < NCH; ++cc) { lbl[64 + cc] = m; m = fmaxf(lbl[cc] + m, lbl[32 + cc]); lbl[96 + cc] = m; } }
        __syncthreads();
        const float mprev = lbl[64 + c], mnew = lbl[96 + c];
        float* WK = F.smallf + SW_WK + (size_t)item * SEQ + tb; float* CS = F.smallf + SW_CS + (size_t)item * SEQ + tb; float* EA = F.smallf + SW_EA + (size_t)item * SEQ + tb;
#pragma unroll
        for (int s = 0; s < 16; ++s) { WK[s] = __expf(blast - bb[s] + fi[s] - mnew); CS[s] = __expf(fi[s] - bb[s] - mprev); EA[s] = __expf(-(bb[s] + mprev)); }
        if ((lane & 15) == 0) F.smallf[SW_DEC + item * NCH + c] = __expf(blast + mprev - mnew);
        __syncthreads();
    }
}
struct SchedPlain {
    const char* A; const char* B; char* O; int lda, ldb, ldc, nM, nN, G, c;
    __device__ __forceinline__ bool next(int i, const char*& a, const char*& b) const {
        const int L = i * G + c; if (L >= nM * nN) return false; int pm, pn; tile_map(L, nM, nN, pm, pn);
        a = A + (size_t)pm * 256 * lda * 2; b = B + (size_t)pn * 256 * ldb * 2; return true; }
    __device__ __forceinline__ void tile(int i, int& pm, int& pn) const { tile_map(i * G + c, nM, nN, pm, pn); }
    __device__ __forceinline__ void info(int i, EU& e) const { int pm, pn; tile(i, pm, pn);
        e.o = O + ((size_t)pm * 256 * ldc + pn * 256) * 2; e.ldc = ldc; e.cs = nullptr; e.rw = nullptr; e.rs = nullptr; e.rs2 = nullptr; e.rstride = 0; e.rslot = 0; e.causal = 0; }
};
struct SchedQK {
    const char* XC; const char* Wq; const char* Wk; char* AQ; char* KB; int bsel, G, c;
    __device__ __forceinline__ void decode(int i, int& ty, int& z, int& pn) const { const int u = xremap(i * G + c, 512); ty = ((u >> 1) ^ (u >> 5)) & 1; z = u >> 2; pn = u & 1; }
    __device__ __forceinline__ bool next(int i, const char*& a, const char*& b) const {
        if (i * G + c >= 512) return false; int ty, z, pn; decode(i, ty, z, pn); const int h = z >> 5, ch = z & 31;
        a = XC + ((size_t)(bsel * SEQ + ch * 256) * DI + h * DH) * 2; b = (ty ? Wk : Wq) + ((size_t)(h * DH + pn * 256) * DH) * 2; return true; }
};
struct EpiQK {
    static constexpr bool PERM = true;
    SchedQK S; char* KWT; const float* WK; float* DN;
    __device__ __forceinline__ void operator()(const pg8::f32x4 (&acc)[2][2][4][2], int ui, int wr, int wc, int fr, int fq) const {
        int ty, z, pn; S.decode(ui, ty, z, pn); const int h = z >> 5, ch = z & 31;
        bf16* base; int ldc;
        if (ty == 0) { base = (bf16*)(S.AQ + ((size_t)z * 256 * 768 + 256 + pn * 256) * 2); ldc = 768; } else { base = (bf16*)(S.KB + ((size_t)(ch * 256) * DI + h * DH + pn * 256) * 2); ldc = DI; }
        asm volatile("" : "+s"(ldc));
        const int colb = wc * 32 + 8 * fq;
        float wt[2][4];
        { const float* wk = WK + (size_t)(S.bsel * NH + h) * SEQ + ch * 256;
#pragma unroll
          for (int ai = 0; ai < 2; ++ai)
#pragma unroll
            for (int m = 0; m < 4; ++m) wt[ai][m] = ty ? wk[ai * 128 + wr * 64 + m * 16 + fr] : 1.f; }
#pragma unroll
        for (int ai = 0; ai < 2; ++ai)
#pragma unroll
            for (int m = 0; m < 4; ++m) {
                const int row = ai * 128 + wr * 64 + m * 16 + fr;
#pragma unroll
                for (int bj = 0; bj < 2; ++bj) { const f32x4 v0 = acc[ai][bj][m][0], v1 = acc[ai][bj][m][1];
                    v4u w; w.x = pg8::cvt_pk_bf16(v0[0], v0[1]); w.y = pg8::cvt_pk_bf16(v0[2], v0[3]); w.z = pg8::cvt_pk_bf16(v1[0], v1[1]); w.w = pg8::cvt_pk_bf16(v1[2], v1[3]);
                    *(v4u*)(base + (unsigned)(row * ldc + bj * 128 + colb)) = w; }
            }
        if (ty) {
            bf16* kt = (bf16*)(KWT + ((size_t)(z * 512 + pn * 256) * 256) * 2);
            const unsigned one = (fr & 1) ? 0x3F800000u : 0x00003F80u; const int wsel = (fr & 7) >> 1;
            const bool on0 = (fq == (fr >> 3)), on1 = (fq == 2 + (fr >> 3));
            pg8::u32x4 s0, s1;
#pragma unroll
            for (int i = 0; i < 4; ++i) { s0[i] = (on0 && wsel == i) ? one : 0u; s1[i] = (on1 && wsel == i) ? one : 0u; }
            const pg8::bf16x8 sel0 = __builtin_bit_cast(pg8::bf16x8, s0), sel1 = __builtin_bit_cast(pg8::bf16x8, s1);
            float cs[2][2] = {{0.f, 0.f}, {0.f, 0.f}};
            unsigned fb = (unsigned)((wc * 32 + fr) * 256 + wr * 64 + 4 * fq); asm volatile("" : "+v"(fb));
#pragma unroll
            for (int ai = 0; ai < 2; ++ai)
#pragma unroll
                for (int m = 0; m < 4; ++m) {
#pragma unroll
                    for (int bj = 0; bj < 2; ++bj) { const f32x4 v0 = acc[ai][bj][m][0] * wt[ai][m], v1 = acc[ai][bj][m][1] * wt[ai][m];
                        pg8::u32x4 pa; pa[0] = pg8::cvt_pk_bf16(v0[0], v0[1]); pa[1] = pg8::cvt_pk_bf16(v0[2], v0[3]); pa[2] = pg8::cvt_pk_bf16(v1[0], v1[1]); pa[3] = pg8::cvt_pk_bf16(v1[2], v1[3]);
                        const pg8::bf16x8 a = __builtin_bit_cast(pg8::bf16x8, pa);
                        const f32x4 d0 = __builtin_amdgcn_mfma_f32_16x16x32_bf16(a, sel0, (f32x4){0.f, 0.f, 0.f, 0.f}, 0, 0, 0), d1 = __builtin_amdgcn_mfma_f32_16x16x32_bf16(a, sel1, (f32x4){0.f, 0.f, 0.f, 0.f}, 0, 0, 0);
                        const unsigned o = fb + (unsigned)(bj * 128 * 256 + ai * 128 + m * 16);
                        v2u w0, w1; w0.x = pg8::cvt_pk_bf16(d0[0], d0[1]); w0.y = pg8::cvt_pk_bf16(d0[2], d0[3]); w1.x = pg8::cvt_pk_bf16(d1[0], d1[1]); w1.y = pg8::cvt_pk_bf16(d1[2], d1[3]);
                        *(v2u*)(kt + o) = w0; *(v2u*)(kt + o + 16 * 256) = w1;
                        cs[bj][0] += (d0[0] + d0[1]) + (d0[2] + d0[3]); cs[bj][1] += (d1[0] + d1[1]) + (d1[2] + d1[3]); }
                }
            float* dn = DN + (((size_t)((S.bsel * NH + h) * NCH + ch)) * DH + pn * 256) * 2 + wr;
#pragma unroll
            for (int bj = 0; bj < 2; ++bj)
#pragma unroll
                for (int j = 0; j < 2; ++j) { float v = xsum32(xsum16(cs[bj][j]));
                    if (fq == 0) dn[(bj * 128 + wc * 32 + j * 16 + fr) * 2] = v; }
        }
    }
};
struct SchedKV {
    const char* XM; const char* Wv; char* BC; int bsel, G, c;
    __device__ __forceinline__ bool next(int i, const char*& a, const char*& b) const {
        if (i * G + c >= 256) return false; const int L = xremap(i * G + c, 256); const int z = L >> 1, pm = L & 1, h = z >> 5, ch = z & 31;
        a = Wv + ((size_t)(h * DH + pm * 256) * DH) * 2; b = XM + ((size_t)(bsel * SEQ + ch * 256) * DI + h * DH) * 2; return true; }
    __device__ __forceinline__ void info(int i, EU& e) const {
        const int L = xremap(i * G + c, 256); const int z = L >> 1, pm = L & 1;
        e.rw = nullptr; e.rs2 = nullptr; e.causal = 0; e.rslot = 0;
        e.o = BC + ((size_t)(z * 512 + pm * 256) * 768) * 2; e.ldc = 768; e.cs = nullptr; e.rs = nullptr; e.rstride = 0; }
};
struct SchedS {
    char* AQ; const char* KB; const float* CS; float* DENI; int bsel, G, c;
    __device__ __forceinline__ int zof(int i) const { if (G == 256) { const int x = c & 7, j = c >> 3; return (i == 0 && j < 16) ? 16 * x + j : -1; } const int L = i * G + c; return L < 128 ? L : -1; }
    __device__ __forceinline__ bool next(int i, const char*& a, const char*& b) const {
        const int z = zof(i); if (z < 0) return false; const int h = z >> 5, ch = z & 31;
        a = AQ + ((size_t)z * 256 * 768 + 256) * 2; b = KB + ((size_t)(ch * 256) * DI + h * DH) * 2; return true; }
    __device__ __forceinline__ void info(int i, EU& e) const {
        const int z = zof(i), h = z >> 5, ch = z & 31;
        e.o = AQ + ((size_t)z * 256 * 768) * 2; e.ldc = 768; e.cs = CS + (size_t)(bsel * NH + h) * SEQ + ch * 256; e.rw = nullptr;
        e.rs = DENI + ((size_t)(bsel * NH + h) * SEQ + ch * 256) * 4; e.rs2 = nullptr; e.rstride = 4; e.rslot = 1; e.causal = 1; }
};
struct SchedDC {
    char* BC; const char* KWT; int G, c;
    __device__ __forceinline__ int lin(int i) const {
        if (G == 256) { const int x = c & 7, j = c >> 3;
            if (j < 16) return i == 0 ? 4 * (16 * x + 12 + (j >> 2)) + (j & 3) : -1;
            return i < 3 ? 4 * (16 * x + i * 4 + ((j - 16) >> 2)) + ((j - 16) & 3) : -1; }
        const int L = i * G + c; return L < 512 ? L : -1; }
    __device__ __forceinline__ bool next(int i, const char*& a, const char*& b) const {
        const int L = lin(i); if (L < 0) return false; const int z = L >> 2, pm = (L >> 1) & 1, pn = L & 1;
        a = BC + ((size_t)(z * 512 + pm * 256) * 768) * 2; b = KWT + ((size_t)(z * 512 + pn * 256) * 256) * 2; return true; }
    __device__ __forceinline__ void info(int i, EU& e) const {
        const int L = lin(i); const int z = L >> 2, pm = (L >> 1) & 1, pn = L & 1;
        e.o = BC + ((size_t)(z * 512 + pm * 256) * 768 + 256 + pn * 256) * 2; e.ldc = 768; e.cs = nullptr; e.rw = nullptr; e.rs = nullptr; e.rs2 = nullptr; e.rstride = 0; e.rslot = 0; e.causal = 0; }
};
struct SchedH {
    const char* AQ; const char* BC; char* HB; const float* DENF; float* HSTAT; int bsel, G, c;
    __device__ __forceinline__ bool next(int i, const char*& a, const char*& b) const {
        if (i * G + c >= 256) return false; const int L = xremap(i * G + c, 256); const int z = L >> 1, pn = L & 1;
        a = AQ + ((size_t)z * 256 * 768) * 2; b = BC + ((size_t)(z * 512 + pn * 256) * 768) * 2; return true; }
    __device__ __forceinline__ void info(int i, EU& e) const {
        const int L = xremap(i * G + c, 256); const int z = L >> 1, pn = L & 1, h = z >> 5, ch = z & 31;
        const size_t row0 = (size_t)bsel * SEQ + ch * 256;
        e.o = HB + (row0 * DI + h * DH + pn * 256) * 2; e.ldc = DI; e.cs = nullptr; e.rw = DENF + (size_t)(bsel * NH + h) * SEQ + ch * 256;
        e.rs = HSTAT + (row0 * NH + h) * 16 + pn * 8; e.rs2 = e.rs + 1; e.rstride = NH * 16; e.rslot = 2; e.causal = 0; }
};

__device__ __forceinline__ void p6_phase(Frame& F, int bsel) {
    bf16* BC = (bf16*)(F.ws + WS_BC); const float* DEC = F.smallf + SW_DEC;
    {
        const int gt = F.bx * NTHR + F.tid, NGT = F.G * NTHR;
        for (int e = gt; e < NH * DH * (DH / 8); e += NGT) {
            const int h = e / (DH * 64), v = (e / 64) % DH, kv = e % 64;
            const float* dec = DEC + (bsel * NH + h) * NCH;
            bf16* p = BC + ((size_t)(h * NCH) * 512 + v) * 768 + 256 + kv * 8;
            float carry[8];
#pragma unroll
            for (int j = 0; j < 8; ++j) carry[j] = 0.f;
            v4u dv[NCH];
#pragma unroll
            for (int c = 0; c < NCH; ++c) dv[c] = *(const v4u*)(p + (size_t)c * 512 * 768);
#pragma unroll
            for (int c = 0; c < NCH; ++c) {
                v4u* q = (v4u*)(p + (size_t)c * 512 * 768);
                const v4u d = dv[c]; const float dc = dec[c];
                v4u o; o.x = pk2(carry[0], carry[1]); o.y = pk2(carry[2], carry[3]); o.z = pk2(carry[4], carry[5]); o.w = pk2(carry[6], carry[7]);
                *q = o;
                carry[0] = carry[0] * dc + bflo(d.x); carry[1] = carry[1] * dc + bfhi(d.x); carry[2] = carry[2] * dc + bflo(d.y); carry[3] = carry[3] * dc + bfhi(d.y);
                carry[4] = carry[4] * dc + bflo(d.z); carry[5] = carry[5] * dc + bfhi(d.z); carry[6] = carry[6] * dc + bflo(d.w); carry[7] = carry[7] * dc + bfhi(d.w);
            }
        }
    }
    {
        LAS float* nv = (LAS float*)(F.lds + RING_OFF);
        const bf16* AQ = (const bf16*)(F.ws + WS_AQ);
        const float* DN = F.ctlf + CW_DN; const float* DENI = F.ctlf + CW_DENI; const float* EA = F.smallf + SW_EA; float* DENF = F.smallf + SW_DENF;
        for (int u = F.bx; u < NH * NCH * 2; u += F.G) {
            const int z = u >> 1, half = u & 1, h = z >> 5, ch = z & 31, bh = bsel * NH + h;
            __syncthreads();
            { const int k = F.tid; float n = 0.f; const float* dec = DEC + bh * NCH; const float* dn = DN + ((size_t)bh * NCH * DH + k) * 2;
#pragma unroll 8
              for (int c = 0; c < ch; ++c) { const pg8::f32x2 d2 = *(const pg8::f32x2*)(dn + (size_t)c * DH * 2); n = n * dec[c] + (d2[0] + d2[1]); }
              nv[k] = n; }
            __syncthreads();
            const int t = half * 128 + (F.tid >> 2), qd = F.tid & 3;
            const v4u* qp = (const v4u*)(AQ + ((size_t)z * 256 + t) * 768 + 256 + qd * 128);
            v4u qv[16];
#pragma unroll
            for (int i = 0; i < 16; ++i) qv[i] = qp[i];
            float s = 0.f;
#pragma unroll
            for (int i = 0; i < 16; ++i) { const LAS f32x4* np = (const LAS f32x4*)(nv + qd * 128 + i * 8); const f32x4 n0 = np[0], n1 = np[1];
                s += bflo(qv[i].x) * n0[0] + bfhi(qv[i].x) * n0[1] + bflo(qv[i].y) * n0[2] + bfhi(qv[i].y) * n0[3] + bflo(qv[i].z) * n1[0] + bfhi(qv[i].z) * n1[1] + bflo(qv[i].w) * n1[2] + bfhi(qv[i].w) * n1[3]; }
            s = dpp_add<0xB1, 0xF>(s); s = dpp_add<0x4E, 0xF>(s);
            if (qd == 0) { const size_t ti = (size_t)bh * SEQ + ch * 256 + t; const f32x4 d4 = *(const f32x4*)(DENI + ti * 4); const float den = ((d4[0] + d4[1]) + (d4[2] + d4[3])) + s; DENF[ti] = 1.f / fmaxf(fabsf(den), EA[ti]); }
        }
    }
}

struct EpiZ {
    static constexpr bool PERM = true;
    SchedPlain S; const bf16* HB; const bf16* XC; const float* HSTAT; const float* gn; const float* skip;
    __device__ __forceinline__ void operator()(const pg8::f32x4 (&acc)[2][2][4][2], int ui, int wr, int wc, int fr, int fq) const {
        int pm, pn; S.tile(ui, pm, pn);
        bf16* O = (bf16*)S.O; const int head = pn >> 1;
        const int colb = pn * 256 + wc * 32 + 8 * fq;
        f32x4 g4[2][2], s4[2][2];
#pragma unroll
        for (int bj = 0; bj < 2; ++bj)
#pragma unroll
            for (int n = 0; n < 2; ++n) { g4[bj][n] = *(const f32x4*)(gn + colb + bj * 128 + 4 * n); s4[bj][n] = *(const f32x4*)(skip + colb + bj * 128 + 4 * n); }
#pragma unroll
        for (int ai = 0; ai < 2; ++ai)
#pragma unroll
            for (int m = 0; m < 4; ++m) {
                const size_t row = (size_t)pm * 256 + ai * 128 + wr * 64 + m * 16 + fr;
                const f32x4* sp = (const f32x4*)(HSTAT + (row * NH + head) * 16); const f32x4 q0 = sp[0], q1 = sp[1], q2 = sp[2], q3 = sp[3];
                const float ssum = ((q0[0] + q0[2]) + (q1[0] + q1[2])) + ((q2[0] + q2[2]) + (q3[0] + q3[2])), ssq = ((q0[1] + q0[3]) + (q1[1] + q1[3])) + ((q2[1] + q2[3]) + (q3[1] + q3[3]));
                const float mu = ssum * (1.f / DH); const float var = fmaxf(ssq * (1.f / DH) - mu * mu, 0.f); const float rstd = rsqrtf(var + LN_EPS);
#pragma unroll
                for (int bj = 0; bj < 2; ++bj) {
                    const size_t off = row * DI + colb + bj * 128;
                    const v4u hb = *(const v4u*)(HB + off), xb = *(const v4u*)(XC + off);
                    const float hv[8] = {bflo(hb.x), bfhi(hb.x), bflo(hb.y), bfhi(hb.y), bflo(hb.z), bfhi(hb.z), bflo(hb.w), bfhi(hb.w)};
                    const float xv[8] = {bflo(xb.x), bfhi(xb.x), bflo(xb.y), bfhi(xb.y), bflo(xb.z), bfhi(xb.z), bflo(xb.w), bfhi(xb.w)};
                    float r[8];
#pragma unroll
                    for (int j = 0; j < 8; ++j) { const float zz = acc[ai][bj][m][j >> 2][j & 3]; const float hn = (hv[j] - mu) * rstd;
                        r[j] = (hn * g4[bj][j >> 2][j & 3] + s4[bj][j >> 2][j & 3] * xv[j]) * silu_f(zz); }
                    v4u w; w.x = pg8::cvt_pk_bf16(r[0], r[1]); w.y = pg8::cvt_pk_bf16(r[2], r[3]); w.z = pg8::cvt_pk_bf16(r[4], r[5]); w.w = pg8::cvt_pk_bf16(r[6], r[7]);
                    *(v4u*)(O + off) = w;
                }
            }
    }
};

struct EpiRes {
    static constexpr bool PERM = true;
    SchedPlain S; const float* X; float* U; const float* cond; int goff;
    __device__ __forceinline__ void operator()(const pg8::f32x4 (&acc)[2][2][4][2], int ui, int wr, int wc, int fr, int fq) const {
        int pm, pn; S.tile(ui, pm, pn);
        const int b = (pm * 256) / SEQ; const int colb = pn * 256 + wc * 32 + 8 * fq;
        f32x4 g4[2][2];
#pragma unroll
        for (int bj = 0; bj < 2; ++bj)
#pragma unroll
            for (int n = 0; n < 2; ++n) g4[bj][n] = *(const f32x4*)(cond + b * NMOD + goff + colb + bj * 128 + 4 * n) + 1.f;
#pragma unroll
        for (int ai = 0; ai < 2; ++ai)
#pragma unroll
            for (int m = 0; m < 4; ++m) {
                const size_t row = (size_t)pm * 256 + ai * 128 + wr * 64 + m * 16 + fr;
#pragma unroll
                for (int bj = 0; bj < 2; ++bj)
#pragma unroll
                    for (int n = 0; n < 2; ++n) { const size_t off = row * DM + colb + bj * 128 + 4 * n;
                        const f32x4 xv = *(const f32x4*)(X + off); *(f32x4*)(U + off) = xv * DN_ALPHA + g4[bj][n] * acc[ai][bj][m][n]; }
            }
    }
};
__device__ __forceinline__ void ln_row(f32x4 (&v)[4], const float* g, const float* b, int lane) {
    float s = 0.f;
#pragma unroll
    for (int j = 0; j < 4; ++j) s += (v[j][0] + v[j][1]) + (v[j][2] + v[j][3]);
    const float mean = wave_sum_dpp(s) * (1.f / DM); float s2 = 0.f;
#pragma unroll
    for (int j = 0; j < 4; ++j) { v[j] = v[j] - mean; s2 += (v[j][0] * v[j][0] + v[j][1] * v[j][1]) + (v[j][2] * v[j][2] + v[j][3] * v[j][3]); }
    const float rstd = rsqrtf(wave_sum_dpp(s2) * (1.f / DM) + LN_EPS);
#pragma unroll
    for (int j = 0; j < 4; ++j) { const int col = 4 * lane + 256 * j; v[j] = v[j] * rstd * *(const f32x4*)(g + col) + *(const f32x4*)(b + col); }
}

__device__ __forceinline__ void fin_test_phase(Frame& F, const float* U, int nskip_from) {
    const float* lng = KIN(F, I_LNG); const float* lnb = KIN(F, I_LNB);
    const int gw = F.bx * NWAVES + F.wave, NGW = F.G * NWAVES;
    for (int m = gw; m < M; m += NGW) {
        f32x4 v[4];
#pragma unroll
        for (int j = 0; j < 4; ++j) v[j] = *((const GAS f32x4*)(U + (size_t)m * DM) + F.lane + 64 * j);
        for (int s = nskip_from; s < 4; ++s) {
#pragma unroll
            for (int j = 0; j < 4; ++j) v[j] = v[j] * DN_ALPHA;
            ln_row(v, lng + s * DM, lnb + s * DM, F.lane);
        }
        if (m == 0 && F.lane == 0) { const unsigned d = F.ctl[CW_DBG]; if (d) v[0][0] = 4096.f * exp2f((float)d * 0.830482f); }
#pragma unroll
        for (int j = 0; j < 4; ++j) *((GAS f32x4*)(F.out + (size_t)m * DM) + F.lane + 64 * j) = v[j];
    }
}

constexpr int LDS_TAB_OFF = LDSCTL_OFF + 1024;

template <bool HASX>
__device__ __forceinline__ void moe_route_phase(Frame& F, const float* X, const bf16* XH, int xh_off, const bf16* Y, bf16* HM, int layer, int lnidx, int cslot, int rflags = 0) {
    LAS float* wrT = (LAS float*)(F.lds + RING_OFF);
    { const float* wr = KIN(F, I_MWR); for (int i = F.tid; i < DM * NE; i += NTHR) wrT[(i & 15) * DM + (i >> 4)] = wr[i]; }
    const float* br = KIN(F, I_MBR);
    const float* cond = F.ctlf + CW_COND;
    int* IDX = (int*)(F.smallf + SW_IDX); float* WTS = F.smallf + SW_WTS; int* POS = (int*)(F.smallf + SW_POS);
    int* cnt = (int*)(F.ctl + CW_MOECNT + cslot * 1024);
    LAS int* lcnt = (LAS int*)(F.lds + RING_OFF + 65536);
    LAS float* prm = (LAS float*)(F.lds + RING_OFF + 74240);
    {
        const float* lng = KIN(F, I_LNG) + lnidx * DM; const float* lnb = KIN(F, I_LNB) + lnidx * DM;
        for (int i = F.tid; i < 2 * DM; i += NTHR) { const int b = i >> 10, col = i & 1023; const float* cb = cond + b * NMOD; LAS float* pb = prm + b * 5 * DM + col;
            const float sc1 = cb[mod_off(layer, 1, 1) + col] + 1.f;
            pb[0] = cb[mod_off(layer, 0, 2) + col] + 1.f; pb[DM] = lng[col] * sc1; pb[2 * DM] = lnb[col] * sc1 + cb[mod_off(layer, 1, 0) + col];
            if (!HASX) { pb[3 * DM] = cb[xh_off + col]; pb[4 * DM] = 1.f / (cb[xh_off + DM + col] + 1.f); } }
    }
    if (F.tid < 32) lcnt[F.tid] = 0;
    __syncthreads();
    const int gw = F.bx * NWAVES + F.wave, NGW = F.G * NWAVES, lane = F.lane;
    const bool b5 = (lane & 32) != 0, b4 = (lane & 16) != 0, b3 = (lane & 8) != 0, b2 = (lane & 4) != 0;
    LAS float* lgbuf = (LAS float*)(lcnt + 64) + F.wave * 256;
    f32x4 cx[2][4], nx[2][4]; v2u ch[2][4], nh[2][4], cy[2][4], ny[2][4];
#define ROUTE_LOAD(mp_, xx, hh, yy) do { _Pragma("unroll") for (int q_ = 0; q_ < 2; ++q_) _Pragma("unroll") for (int j_ = 0; j_ < 4; ++j_) { const size_t ro_ = (size_t)((mp_) * 2 + q_) * DM; \
        if (HASX) xx[q_][j_] = *((const GAS f32x4*)(X + ro_) + lane + 64 * j_); else hh[q_][j_] = *((const GAS v2u*)(XH + ro_) + lane + 64 * j_); \
        yy[q_][j_] = __builtin_nontemporal_load((const GAS v2u*)(Y + ro_) + lane + 64 * j_); } } while (0)
    if (gw < M / 2) ROUTE_LOAD(gw, cx, ch, cy);
    int it = 0;
    for (int mp = gw; mp < M / 2; mp += NGW, ++it) {
        const int m0 = mp * 2; const int b = m0 / SEQ;
        if (mp + NGW < M / 2) ROUTE_LOAD(mp + NGW, nx, nh, ny);
        unsigned wofs = 0; asm volatile("" : "+v"(wofs));
        LAS const float* wrL = wrT + wofs; LAS const float* pb = prm + wofs + b * 5 * DM;
        f32x4 vv[2][4];
#pragma unroll
        for (int q = 0; q < 2; ++q)
#pragma unroll
            for (int j = 0; j < 4; ++j) { f32x4 xv; const int col = 4 * lane + 256 * j;
                if (HASX) xv = cx[q][j];
                else { const v2u hw = ch[q][j]; const f32x4 hv = (f32x4){bflo(hw.x), bfhi(hw.x), bflo(hw.y), bfhi(hw.y)};
                    xv = (hv - *(const LAS f32x4*)(pb + 3 * DM + col)) * *(const LAS f32x4*)(pb + 4 * DM + col); }
                const v2u yw = cy[q][j];
                vv[q][j] = xv * DN_ALPHA + *(const LAS f32x4*)(pb + col) * (f32x4){bflo(yw.x), bfhi(yw.x), bflo(yw.y), bfhi(yw.y)}; }
#pragma unroll
        for (int q = 0; q < 2; ++q) {
            const int m = m0 + q;
            if (!(rflags & 2)) {
                float s1 = 0.f;
#pragma unroll
                for (int j = 0; j < 4; ++j) s1 += (vv[q][j][0] + vv[q][j][1]) + (vv[q][j][2] + vv[q][j][3]);
                const float mean = wave_sum_dpp(s1) * (1.f / DM); float s2 = 0.f;
#pragma unroll
                for (int j = 0; j < 4; ++j) { vv[q][j] = vv[q][j] - mean; s2 += (vv[q][j][0] * vv[q][j][0] + vv[q][j][1] * vv[q][j][1]) + (vv[q][j][2] * vv[q][j][2] + vv[q][j][3] * vv[q][j][3]); }
                const float rstd = rsqrtf(wave_sum_dpp(s2) * (1.f / DM) + LN_EPS);
#pragma unroll
                for (int j = 0; j < 4; ++j) vv[q][j] = vv[q][j] * rstd;
            }
            float lg[16];
#pragma unroll
            for (int e = 0; e < 16; ++e) lg[e] = 0.f;
#pragma unroll
            for (int j = 0; j < 4; ++j) { const int col = 4 * lane + 256 * j;
                const f32x4 h = vv[q][j] * *(const LAS f32x4*)(pb + DM + col) + *(const LAS f32x4*)(pb + 2 * DM + col);
                v2u w; w.x = pk2(h[0], h[1]); w.y = pk2(h[2], h[3]); *((GAS v2u*)(HM + (size_t)m * DM) + lane + 64 * j) = w;
                if (!(rflags & 1)) {
#pragma unroll
                for (int e = 0; e < 16; ++e) { const f32x4 wv = *(const LAS f32x4*)(wrL + e * DM + col); lg[e] += h[0] * wv[0] + h[1] * wv[1] + h[2] * wv[2] + h[3] * wv[3]; } }
            }
            float a8[8], a4[4], a2[2], a1;
#pragma unroll
            for (int i = 0; i < 8; ++i) { auto r_ = __builtin_amdgcn_permlane32_swap(__float_as_uint(lg[i]), __float_as_uint(lg[8 + i]), false, false); a8[i] = __uint_as_float(r_[0]) + __uint_as_float(r_[1]); }
#pragma unroll
            for (int i = 0; i < 4; ++i) { auto r_ = __builtin_amdgcn_permlane16_swap(__float_as_uint(a8[i]), __float_as_uint(a8[4 + i]), false, false); a4[i] = __uint_as_float(r_[0]) + __uint_as_float(r_[1]); }
#pragma unroll
            for (int i = 0; i < 2; ++i) { const float snd = b3 ? a4[i] : a4[2 + i], kp = b3 ? a4[2 + i] : a4[i]; a2[i] = dpp_add<0x140, 0xF>(kp, snd); }
            { const float snd = b2 ? a2[0] : a2[1], kp = b2 ? a2[1] : a2[0]; a1 = dpp_add<0x141, 0xF>(kp, snd); }
            a1 = dpp_add<0x4E, 0xF>(a1); a1 = dpp_add<0xB1, 0xF>(a1);
            if ((lane & 3) == 0) lgbuf[((it * 2 + q) & 15) * 16 + (lane >> 2)] = a1;
        }
#pragma unroll
        for (int q = 0; q < 2; ++q)
#pragma unroll
            for (int j = 0; j < 4; ++j) { cx[q][j] = nx[q][j]; ch[q][j] = nh[q][j]; cy[q][j] = ny[q][j]; }
    }
#undef ROUTE_LOAD
    LDS_WAIT();
    const int ntok = it * 2;
    int i0 = 0, i1 = 0, lp0 = 0, lp1 = 0; int mtok = -1;
    if (lane < ntok && !(rflags & 4)) {
        mtok = (gw + (lane >> 1) * NGW) * 2 + (lane & 1);
        float lg[16];
#pragma unroll
        for (int e = 0; e < 16; ++e) lg[e] = lgbuf[lane * 16 + e];
        float mx = lg[0];
#pragma unroll
        for (int e = 1; e < 16; ++e) mx = fmaxf(mx, lg[e]);
        float pr[16], sum = 0.f;
#pragma unroll
        for (int e = 0; e < 16; ++e) { pr[e] = __expf(lg[e] - mx); sum += pr[e]; }
        const float inv = 1.f / sum;
        float sel[16];
#pragma unroll
        for (int e = 0; e < 16; ++e) { pr[e] *= inv; sel[e] = pr[e] + br[e]; }
        int gb = 0; float gbest = -INFINITY;
#pragma unroll
        for (int g = 0; g < 4; ++g) {
            const float a = sel[4 * g], bq = sel[4 * g + 1], c = sel[4 * g + 2], d = sel[4 * g + 3];
            const float hi1 = fmaxf(a, bq), lo1 = fminf(a, bq), hi2 = fmaxf(c, d), lo2 = fminf(c, d);
            const float top = fmaxf(hi1, hi2), second = fmaxf(fminf(hi1, hi2), fmaxf(lo1, lo2));
            const float sc = top + second;
            if (sc > gbest) { gbest = sc; gb = g; }
        }
        float s0 = -INFINITY, s1 = -INFINITY; float p0 = 0.f, p1 = 0.f;
#pragma unroll
        for (int e = 0; e < 16; ++e) {
            if ((e >> 2) == gb) {
                const float sv = sel[e];
                if (sv > s0) { s1 = s0; i1 = i0; p1 = p0; s0 = sv; i0 = e; p0 = pr[e]; }
                else if (sv > s1) { s1 = sv; i1 = e; p1 = pr[e]; }
            }
        }
        const float wn = 1.f / (p0 + p1);
        IDX[mtok * 2] = i0; IDX[mtok * 2 + 1] = i1; WTS[mtok * 2] = p0 * wn; WTS[mtok * 2 + 1] = p1 * wn;
        lp0 = __hip_atomic_fetch_add(&lcnt[i0], 1, __ATOMIC_RELAXED, __HIP_MEMORY_SCOPE_WORKGROUP); lp1 = __hip_atomic_fetch_add(&lcnt[i1], 1, __ATOMIC_RELAXED, __HIP_MEMORY_SCOPE_WORKGROUP);
    }
    __syncthreads();
    if (F.tid < NE) lcnt[16 + F.tid] = atomicAdd(cnt + F.tid * 64, lcnt[F.tid]);
    __syncthreads();
    if (mtok >= 0) { int* BT = (int*)(F.smallf + SW_BT); const int q0 = lp0 + lcnt[16 + i0], q1 = lp1 + lcnt[16 + i1];
        POS[mtok * 2] = q0; POS[mtok * 2 + 1] = q1; BT[i0 * BT_CAP + q0] = mtok; BT[i1 * BT_CAP + q1] = mtok; }
}
__device__ __forceinline__ int moe_pstart(const int* cnt, int e) { int s = 0; for (int q = 0; q < e; ++q) s += ((cnt[q * 64] + 255) >> 8) << 8; return s; }

__device__ __forceinline__ int moe_build_table(Frame& F, int layer) {
    const int* cnt = (const int*)(F.ctl + CW_MOECNT + layer * 1024);
    LAS int* tab = (LAS int*)(F.lds + LDS_TAB_OFF);
    int nb = 0;
    for (int e = 0; e < NE; ++e) { const int c = cnt[e * 64], k = (c + 255) >> 8; if (F.tid < k) tab[nb + F.tid] = e | (F.tid << 4); if (F.tid == 0) { tab[256 + e] = c; tab[272 + e] = nb * 256; } nb += k; }
    __syncthreads();
    return nb;
}
struct SchedMoe {
    const char* A; const char* W; char* O; LAS const int* tab; const int* buftok; int gather; int lda, ldb, ldc, ocols, wrows;
    int nbx4, blk0, Gx, j, x, split, base, R, qh, Hn, Lc;
    __device__ __forceinline__ void map(int nb, int G, int c, int split_) {
        x = c & 7; j = c >> 3; Gx = (G + 7 - x) >> 3; const int q = nb >> 3, r = nb & 7; nbx4 = 4 * (q + (x < r ? 1 : 0)); blk0 = x * q + (x < r ? x : r);
        split = split_; base = nbx4 / Gx; R = nbx4 - base * Gx; qh = base >= 1 ? base - 1 : 0; Hn = R * qh; Lc = Gx - R; }
    __device__ __forceinline__ int off(int i) const {
        if (!split) { const int o = j + Gx * i; return o < nbx4 ? o : -1; }
        if (j < R) return i < qh ? nbx4 - Hn + i * R + j : -1;
        const int o = i * Lc + (j - R); return o < nbx4 - Hn ? o : -1; }
    __device__ __forceinline__ int count() const { int n = 0; while (off(n) >= 0) ++n; return n; }
    __device__ __forceinline__ bool next(int i, const char*& a, const char*& b) const {
        const int o = off(i); if (o < 0) return false; const int rb = blk0 + (o >> 2), pn = o & 3; const int e = __builtin_amdgcn_readfirstlane(tab[rb]) & 15;
        a = gather ? A : A + (size_t)rb * 256 * lda * 2; b = W + ((size_t)e * wrows + pn * 256) * ldb * 2; return true; }
    __device__ __forceinline__ void load_tokens(int i, LAS int* dst, int tid) const { const int rb = blk0 + (off(i) >> 2); const int t = tab[rb], e = t & 15, p = (t >> 4) * 256 + tid;
        if (tid < 256) dst[tid] = p < tab[256 + e] ? buftok[e * BT_CAP + p] : 0; }
    __device__ __forceinline__ void info(int i, EU& e) const { const int o = off(i); const int rb = blk0 + (o >> 2), pn = o & 3;
        e.o = O + ((size_t)rb * 256 * ldc + pn * ocols) * 2; e.ldc = ldc; e.cs = nullptr; e.rw = nullptr; e.rs = nullptr; e.rs2 = nullptr; e.rstride = 0; e.rslot = 0; e.causal = 0; }
};
constexpr int CW_ATQ = CW_LCNT + 2432;
constexpr int CW_XCCTAB = CW_LCNT + 2048;
constexpr int CW_SIG = CW_LCNT + 1024;
__device__ __forceinline__ void moe_signal(unsigned* gctr, LAS unsigned* lctr, bool lane0, bool samex) {
    asm volatile("s_waitcnt vmcnt(0)" ::: "memory");
    if (lane0) {
        const unsigned old = __hip_atomic_fetch_add(lctr, 1u, __ATOMIC_ACQ_REL, __HIP_MEMORY_SCOPE_WORKGROUP);
        if (old == NWAVES - 1) { __hip_atomic_store(lctr, 0u, __ATOMIC_RELAXED, __HIP_MEMORY_SCOPE_WORKGROUP); if (!samex) __builtin_amdgcn_fence(__ATOMIC_RELEASE, "agent"); (void)xb_add(gctr, 1u); }
    }
}
__device__ __forceinline__ bool moe_group_same_xcd(Frame& F, int x, int Gx) {
    const unsigned* tab = F.ctl + CW_XCCTAB; const unsigned mine = xb_xcc_id(); bool same = true;
    for (int jj = 0; jj < Gx; ++jj) same = same && (tab[x + 8 * jj] == mine);
    return same;
}
__device__ __forceinline__ void moe_wait_first(Frame& F, const SchedMoe& S2, bool samex, int sigofs = 0) {
    unsigned* sig = F.ctl + CW_SIG + sigofs;
    bool need2 = false;
    for (int i = 0; ; ++i) { const int o = S2.off(i); if (o < 0) break; if (S2.R > 0 && (o | 3) >= S2.base * S2.Gx) need2 = true; }
    if (S2.base >= 1) { unsigned sp = 0; while (xb_ld(sig + 64 * S2.x) < (unsigned)S2.Gx) { __builtin_amdgcn_s_sleep(2); if (++sp > XB_SPIN_CAP) break; } }
    if (need2) { unsigned sp = 0; while (xb_ld(sig + 512 + 64 * S2.x) < (unsigned)S2.R) { __builtin_amdgcn_s_sleep(2); if (++sp > XB_SPIN_CAP) break; } }
    if (samex) asm volatile("buffer_inv sc0" ::: "memory");
    else __builtin_amdgcn_fence(__ATOMIC_ACQUIRE, "agent");
    __syncthreads();
}
struct EpiMoe1 {
    static constexpr bool PERM = true;
    SchedMoe S; unsigned* sig; LAS unsigned* lctr; bool samex;
    __device__ __forceinline__ void operator()(const pg8::f32x4 (&acc)[2][2][4][2], int ui, int wr, int wc, int fr, int fq) const {
        EU e = {}; S.info(ui, e); asm volatile("" : "+s"(e.ldc));
        bf16* base = (bf16*)e.o; const int colb = wc * 32 + 8 * fq;
#pragma unroll
        for (int ai = 0; ai < 2; ++ai)
#pragma unroll
            for (int m = 0; m < 4; ++m) {
                const int row = ai * 128 + wr * 64 + m * 16 + fr;
                float r[8];
#pragma unroll
                for (int j = 0; j < 8; ++j) { const float g = acc[ai][0][m][j >> 2][j & 3], u = acc[ai][1][m][j >> 2][j & 3]; r[j] = silu_f(g) * u; }
                v4u w; w.x = pg8::cvt_pk_bf16(r[0], r[1]); w.y = pg8::cvt_pk_bf16(r[2], r[3]); w.z = pg8::cvt_pk_bf16(r[4], r[5]); w.w = pg8::cvt_pk_bf16(r[6], r[7]);
                *(v4u*)(base + (unsigned)(row * e.ldc + colb)) = w;
            }
        if (sig) { if (ui == S.base - 1) moe_signal(sig + 64 * S.x, lctr, (fr | fq) == 0, samex); else if (ui == S.base) moe_signal(sig + 512 + 64 * S.x, lctr, (fr | fq) == 0, samex); }
    }
};
__device__ __forceinline__ void moe_combine_phase(Frame& F, const bf16* HM, const bf16* YS, float* XO, int layer, int lnidx, bf16* H1, bf16* HKV) {
    const float* lng = KIN(F, I_LNG) + lnidx * DM; const float* lnb = KIN(F, I_LNB) + lnidx * DM; const float* cond = F.ctlf + CW_COND;
    const float* WTS = F.smallf + SW_WTS; const int* POS = (const int*)(F.smallf + SW_POS); const int* IDX = (const int*)(F.smallf + SW_IDX);
    LAS int* pst = (LAS int*)(F.lds + LDS_TAB_OFF) + 272;
    if (F.tid < NE) pst[F.tid] = moe_pstart((const int*)(F.ctl + CW_MOECNT + layer * 1024), F.tid);
    const int gw = F.bx * NWAVES + F.wave, NGW = F.G * NWAVES, lane = F.lane;
    LAS float* prm = (LAS float*)(F.lds + RING_OFF);
    for (int i = F.tid; i < 2 * DM; i += NTHR) { const int b = i >> 10, col = i & 1023; const float* cb = cond + b * NMOD; LAS float* pb = prm + b * 7 * DM + col;
        const float g_ = lng[col], b_ = lnb[col];
        pb[0] = DN_ALPHA * __builtin_amdgcn_rcpf(cb[mod_off(layer, 1, 1) + col] + 1.f); pb[DM] = cb[mod_off(layer, 1, 0) + col]; pb[2 * DM] = cb[mod_off(layer, 1, 2) + col] + 1.f;
        if (H1) { const float sc1 = cb[mod_off(layer + 1, 0, 1) + col] + 1.f, sc2 = cb[13 * DM + col] + 1.f;
            pb[3 * DM] = g_ * sc1; pb[4 * DM] = b_ * sc1 + cb[mod_off(layer + 1, 0, 0) + col]; pb[5 * DM] = g_ * sc2; pb[6 * DM] = b_ * sc2 + cb[12 * DM + col]; }
        else { pb[3 * DM] = g_; pb[4 * DM] = b_; } }
    __syncthreads();
    int rrN[2][2]; float wwN[2][2]; v2u xN[2][4], yaN[2][4], ycN[2][4];
#define CMB_IDX(mp_, R_, W_) do { _Pragma("unroll") for (int q_ = 0; q_ < 2; ++q_) { const int m_ = (mp_) * 2 + q_; R_[q_][0] = POS[m_ * 2] + pst[IDX[m_ * 2]]; R_[q_][1] = POS[m_ * 2 + 1] + pst[IDX[m_ * 2 + 1]]; W_[q_][0] = WTS[m_ * 2]; W_[q_][1] = WTS[m_ * 2 + 1]; } } while (0)
#define CMB_ROWS(mp_, R_, X_, A_, C_) do { _Pragma("unroll") for (int q_ = 0; q_ < 2; ++q_) _Pragma("unroll") for (int j_ = 0; j_ < 4; ++j_) { \
        X_[q_][j_] = __builtin_nontemporal_load((const GAS v2u*)(HM + (size_t)((mp_) * 2 + q_) * DM) + lane + 64 * j_); A_[q_][j_] = __builtin_nontemporal_load((const GAS v2u*)(YS + (size_t)R_[q_][0] * DM) + lane + 64 * j_); C_[q_][j_] = __builtin_nontemporal_load((const GAS v2u*)(YS + (size_t)R_[q_][1] * DM) + lane + 64 * j_); } } while (0)
    if (gw < M / 2) { CMB_IDX(gw, rrN, wwN); CMB_ROWS(gw, rrN, xN, yaN, ycN); }
    for (int mp = gw; mp < M / 2; mp += NGW) {
        const int m0 = mp * 2;
        const int b = m0 / SEQ; LAS const float* pb = prm + b * 7 * DM;
        float ww[2][2]; v2u x[2][4], ya[2][4], yc[2][4];
#pragma unroll
        for (int q = 0; q < 2; ++q) { ww[q][0] = wwN[q][0]; ww[q][1] = wwN[q][1];
#pragma unroll
            for (int j = 0; j < 4; ++j) { x[q][j] = xN[q][j]; ya[q][j] = yaN[q][j]; yc[q][j] = ycN[q][j]; } }
        if (mp + NGW < M / 2) { CMB_IDX(mp + NGW, rrN, wwN); CMB_ROWS(mp + NGW, rrN, xN, yaN, ycN); }
#pragma unroll
        for (int q = 0; q < 2; ++q) {
            const int m = m0 + q; f32x4 v[4];
#pragma unroll
            for (int j = 0; j < 4; ++j) { const int col = 4 * lane + 256 * j;
                const f32x4 a = (f32x4){bflo(ya[q][j].x), bfhi(ya[q][j].x), bflo(ya[q][j].y), bfhi(ya[q][j].y)}, c = (f32x4){bflo(yc[q][j].x), bfhi(yc[q][j].x), bflo(yc[q][j].y), bfhi(yc[q][j].y)};
                const f32x4 hv = (f32x4){bflo(x[q][j].x), bfhi(x[q][j].x), bflo(x[q][j].y), bfhi(x[q][j].y)};
                v[j] = (hv - *(LAS const f32x4*)(pb + DM + col)) * *(LAS const f32x4*)(pb + col) + *(LAS const f32x4*)(pb + 2 * DM + col) * (a * ww[q][0] + c * ww[q][1]); }
            float s = 0.f;
#pragma unroll
            for (int j = 0; j < 4; ++j) s += (v[j][0] + v[j][1]) + (v[j][2] + v[j][3]);
            const float mean = wave_sum_dpp(s) * (1.f / DM); float s2 = 0.f;
#pragma unroll
            for (int j = 0; j < 4; ++j) { v[j] = v[j] - mean; s2 += (v[j][0] * v[j][0] + v[j][1] * v[j][1]) + (v[j][2] * v[j][2] + v[j][3] * v[j][3]); }
            const float rstd = rsqrtf(wave_sum_dpp(s2) * (1.f / DM) + LN_EPS);
#pragma unroll
            for (int j = 0; j < 4; ++j) { const int col = 4 * lane + 256 * j; const f32x4 n = v[j] * rstd;
                const f32x4 h = n * *(LAS const f32x4*)(pb + 3 * DM + col) + *(LAS const f32x4*)(pb + 4 * DM + col);
                if (XO) *((GAS f32x4*)(XO + (size_t)m * DM) + lane + 64 * j) = h;
                if (H1) { v2u w; w.x = pk2(h[0], h[1]); w.y = pk2(h[2], h[3]); *((GAS v2u*)(H1 + (size_t)m * DM) + lane + 64 * j) = w; }
                if (HKV) { const f32x4 h2 = n * *(LAS const f32x4*)(pb + 5 * DM + col) + *(LAS const f32x4*)(pb + 6 * DM + col);
                    v2u w; w.x = pk2(h2[0], h2[1]); w.y = pk2(h2[2], h2[3]); *((GAS v2u*)(HKV + (size_t)m * DM) + lane + 64 * j) = w; }
            }
        }
    }
#undef CMB_IDX
#undef CMB_ROWS
}
constexpr int LIST_CAP = 7936;
struct SchedQKV1 {
    const char* H1; const char* HKV; const char* Wq; const char* Wkv; char* Q1; char* K1; char* VT; float* KM; int G, c;
    __device__ __forceinline__ void dec(int i, int& ty, int& pm, int& pn) const { const int L = xremap(i * G + c, 768); ty = L >> 8; const int r = L & 255; if (ty < 2) { pm = r >> 2; pn = r & 3; } else { pm = r & 3; pn = r >> 2; } }
    __device__ __forceinline__ bool next(int i, const char*& a, const char*& b) const {
        if (i * G + c >= 768) return false; int ty, pm, pn; dec(i, ty, pm, pn);
        if (ty == 0) { a = H1 + (size_t)pm * 256 * DM * 2; b = Wq + (size_t)pn * 256 * DM * 2; }
        else if (ty == 1) { a = HKV + (size_t)pm * 256 * DM * 2; b = Wkv + (size_t)pn * 256 * DM * 2; }
        else { a = Wkv + (size_t)(DM + pm * 256) * DM * 2; b = HKV + (size_t)pn * 256 * DM * 2; }
        return true; }
    __device__ __forceinline__ void info(int i, EU& e) const { int ty, pm, pn; dec(i, ty, pm, pn);
        e.cs = nullptr; e.rw = nullptr; e.rs = nullptr; e.rs2 = nullptr; e.rstride = 0; e.rslot = 0; e.causal = 0; e.csum = nullptr;
        if (ty == 0) { e.o = Q1 + ((size_t)pm * 256 * DM + pn * 256) * 2; e.ldc = DM; }
        else if (ty == 1) { e.o = K1 + ((size_t)pm * 256 * DM + pn * 256) * 2; e.ldc = DM; e.csum = KM + ((size_t)pm * DM + pn * 256) * 2; }
        else { e.o = VT + ((size_t)pm * 256 * M + pn * 256) * 2; e.ldc = M; } }
};

struct EpiQKV1 {
    static constexpr bool PERM = true;
    SchedQKV1 S; float* KNP;
    __device__ __forceinline__ void operator()(const pg8::f32x4 (&acc)[2][2][4][2], int ui, int wr, int wc, int fr, int fq) const {
        int ty, pm, pn; S.dec(ui, ty, pm, pn);
        char* o; int ldc;
        if (ty == 0) { o = S.Q1 + ((size_t)pm * 256 * DM + pn * 256) * 2; ldc = DM; }
        else if (ty == 1) { o = S.K1 + ((size_t)pm * 256 * DM + pn * 256) * 2; ldc = DM; }
        else { o = S.VT + ((size_t)pm * 256 * M + pn * 256) * 2; ldc = M; }
        asm volatile("" : "+s"(ldc));
        bf16* base = (bf16*)o; const int colb = wc * 32 + 8 * fq;
        float pmax[2] = {0.f, 0.f};
#pragma unroll
        for (int ai = 0; ai < 2; ++ai)
#pragma unroll
            for (int m = 0; m < 4; ++m) {
                const int row = ai * 128 + wr * 64 + m * 16 + fr;
#pragma unroll
                for (int bj = 0; bj < 2; ++bj) { const f32x4 v0 = acc[ai][bj][m][0], v1 = acc[ai][bj][m][1];
                    v4u w; w.x = pg8::cvt_pk_bf16(v0[0], v0[1]); w.y = pg8::cvt_pk_bf16(v0[2], v0[3]); w.z = pg8::cvt_pk_bf16(v1[0], v1[1]); w.w = pg8::cvt_pk_bf16(v1[2], v1[3]);
                    *(v4u*)(base + (unsigned)(row * ldc + bj * 128 + colb)) = w;
                    if (ty == 1) { float s = (v0[0] * v0[0] + v0[1] * v0[1]) + (v0[2] * v0[2] + v0[3] * v0[3]) + (v1[0] * v1[0] + v1[1] * v1[1]) + (v1[2] * v1[2] + v1[3] * v1[3]);
                        s = xsum32(xsum16(s)); pmax[bj] = fmaxf(pmax[bj], s); } }
            }
        if (ty == 1) {
#pragma unroll
            for (int bj = 0; bj < 2; ++bj) { float p = rowmax16(pmax[bj]);
                if (fr == 0 && fq == 0) KNP[(((size_t)pm * AH + pn * 4 + bj * 2 + (wc >> 1)) * 2 + (wc & 1)) * 2 + wr] = p; }
            float* csum = S.KM + ((size_t)pm * DM + pn * 256) * 2;
            unsigned cbl = (unsigned)(colb * 2 + wr); asm volatile("" : "+v"(cbl));
#pragma unroll
            for (int bj = 0; bj < 2; ++bj)
#pragma unroll
                for (int n = 0; n < 2; ++n) { f32x4 c4 = (f32x4){0.f, 0.f, 0.f, 0.f};
#pragma unroll
                    for (int ai = 0; ai < 2; ++ai)
#pragma unroll
                        for (int m = 0; m < 4; ++m) c4 += acc[ai][bj][m][n];
#pragma unroll
                    for (int j = 0; j < 4; ++j) { float v = rowsum16(c4[j]);
                        if (fr == 0) csum[cbl + (unsigned)((bj * 128 + 4 * n + j) * 2)] = v; } }
        }
    }
};

__device__ __forceinline__ void moba_keynorm_phase(Frame& F) {
    LAS float* red = (LAS float*)(F.lds + RING_OFF);
    const bf16* K1 = (const bf16*)((const char*)F.out + 32 * MiB); float* KN = F.ctlf + CW_KN;
    for (int u0 = F.bx * 2; u0 < BATCH * AH * NBLK; u0 += F.G * 2) {
        const int u = u0 + (F.tid >> 8), b = u >> 9, h = (u >> 5) & 15, n = u & 31, r = F.tid & 255;
        const v4u* kp = (const v4u*)(K1 + (size_t)(b * SEQ + n * 256 + r) * DM + h * HD); float s = 0.f;
#pragma unroll
        for (int i = 0; i < 8; ++i) { const v4u w = kp[i]; const float a0 = bflo(w.x), a1 = bfhi(w.x), a2 = bflo(w.y), a3 = bfhi(w.y), a4 = bflo(w.z), a5 = bfhi(w.z), a6 = bflo(w.w), a7 = bfhi(w.w);
            s += a0 * a0 + a1 * a1 + a2 * a2 + a3 * a3 + a4 * a4 + a5 * a5 + a6 * a6 + a7 * a7; }
#pragma unroll
        for (int o = 1; o < 64; o <<= 1) s = fmaxf(s, __shfl_xor(s, o));
        __syncthreads();
        if (F.lane == 0) red[F.wave] = s;
        __syncthreads();
        if ((F.tid & 255) == 0) { const int w0 = (F.tid >> 8) * 4; KN[u] = sqrtf(fmaxf(fmaxf(red[w0], red[w0 + 1]), fmaxf(red[w0 + 2], red[w0 + 3]))) * 1.01f + 1e-3f; }
    }
    __syncthreads();
}
__device__ __forceinline__ void moba_route_phase(Frame& F, int cslot) {
    const int half = F.tid >> 8, ht = F.tid & 255;
    LAS float* km = (LAS float*)(F.lds + RING_OFF) + half * (32 * 64 + 128);
    LAS int* lcnt = (LAS int*)(km + 32 * 64);
    LAS int* lbase = lcnt + 32;
    LAS float* kn = (LAS float*)(lbase + 32);
    const float* KM = F.ctlf + CW_KM; const float* KNP = F.ctlf + CW_KNP; const bf16* Q1 = (const bf16*)F.out;
    int* LCNT = (int*)(F.ctl + CW_LCNT + cslot * 1024); int* LISTS = (int*)(F.ws + WS_LISTS); float* LSE = (float*)(F.ws + WS_LSE);
    for (int u0 = F.bx * 2; u0 < BATCH * AH * NBLK; u0 += F.G * 2) {
        const int u = u0 + half, b = u >> 9, h = (u >> 5) & 15, j = (u & 31) ^ (((u0 / (F.G * 2)) & 1) ? 31 : 0);
        __syncthreads();
        for (int i = ht; i < j * 64; i += 256) { const int n = i >> 6, d = i & 63; const float* p = KM + ((size_t)(b * NBLK + n) * DM + h * HD + d) * 2; km[i] = (p[0] + p[1]) * (1.f / 256.f); }
        if (ht < 32) { lcnt[ht] = 0; const float* p = KNP + ((size_t)((b * NBLK + ht) * AH + h)) * 4; kn[ht] = sqrtf(fmaxf(p[0], p[1]) + fmaxf(p[2], p[3])) * 1.01f + 1e-3f; }
        __syncthreads();
        int sel[3] = {0, 0, 0}, pos[3] = {-1, -1, -1}; const int nsel = j < 3 ? j : 3;
        const float slope2 = exp2f(-0.5f * (float)(h + 1)) * LOG2E;
        if (j > 0) {
            const int t = j * 256 + ht;
            float q[64];
            const v4u* qp = (const v4u*)(Q1 + (size_t)(b * SEQ + t) * DM + h * HD);
#pragma unroll
            for (int i = 0; i < 8; ++i) { const v4u w = qp[i]; q[8 * i] = bflo(w.x); q[8 * i + 1] = bfhi(w.x); q[8 * i + 2] = bflo(w.y); q[8 * i + 3] = bfhi(w.y); q[8 * i + 4] = bflo(w.z); q[8 * i + 5] = bfhi(w.z); q[8 * i + 6] = bflo(w.w); q[8 * i + 7] = bfhi(w.w); }
            float qq = 0.f;
#pragma unroll
            for (int d = 0; d < 64; ++d) qq += q[d] * q[d];
            const float qn = sqrtf(qq) * 1.01f + 1e-3f;
            float s0 = -INFINITY, s1 = -INFINITY, s2 = -INFINITY;
            for (int n = 0; n < j; ++n) {
                float s = 0.f;
#pragma unroll
                for (int d = 0; d < 64; ++d) s += q[d] * km[n * 64 + d];
                if (s > s0) { s2 = s1; sel[2] = sel[1]; s1 = s0; sel[1] = sel[0]; s0 = s; sel[0] = n; }
                else if (s > s1) { s2 = s1; sel[2] = sel[1]; s1 = s; sel[1] = n; }
                else if (s > s2) { s2 = s; sel[2] = n; }
            }
            for (int k = 0; k < nsel; ++k) {
                const float dmin = (float)(t - (sel[k] * 256 + 255));
                const bool dead = slope2 * dmin - qn * (kn[sel[k]] + kn[j]) - 8.f > 150.f;
                if (dead) LSE[((size_t)(b * SEQ + t) * AH + h) * 4 + k] = -INFINITY;
                else pos[k] = __hip_atomic_fetch_add(&lcnt[sel[k]], 1, __ATOMIC_RELAXED, __HIP_MEMORY_SCOPE_WORKGROUP);
            }
        }
        __syncthreads();
        if (ht < j) lbase[ht] = atomicAdd(LCNT + (b * AH + h) * NBLK + ht, lcnt[ht]);
        __syncthreads();
        for (int k = 0; k < nsel; ++k) if (pos[k] >= 0) LISTS[(size_t)((b * AH + h) * NBLK + sel[k]) * LIST_CAP + lbase[sel[k]] + pos[k]] = ((j * 256 + ht) << 2) | k;
    }
    __syncthreads();
}

__device__ __forceinline__ int crow16(int r, int hi) { return (r & 3) + 8 * (r >> 2) + 4 * hi; }
constexpr int AT_KS = 0, AT_KSTRIDE = 144, AT_VS = 36864, AT_VSTRIDE = 528, AT_STG = 70656, AT_WSF = 103424, AT_PFX = 106496, AT_DUMMY = 114688, AT_ENP = 116736, AT_MBOX = 118784;
constexpr int AT_SEG = 3;
__device__ __forceinline__ void attn_kv_load(Frame& F, int b, int h, int kblk, v4u (&kv)[8]) {
    const bf16* K1 = (const bf16*)((const char*)F.out + 32 * MiB); const bf16* VT = (const bf16*)(F.ws + WS_VT1);
    const int tid = F.tid, r = tid >> 1, half = tid & 1, d = tid >> 3, seg = tid & 7;
    const v4u* src = (const v4u*)(K1 + (size_t)(b * SEQ + kblk * 256 + r) * DM + h * HD + half * 32);
    const v4u* vsrc = (const v4u*)(VT + (size_t)(h * HD + d) * M + b * SEQ + kblk * 256 + seg * 32);
#pragma unroll
    for (int i = 0; i < 4; ++i) { kv[i] = src[i]; kv[4 + i] = vsrc[i]; }
}
__device__ __forceinline__ void attn_unit(Frame& F, int b, int h, int kblk, bool own, const int* list, int cnt, int chunk0, int nchunk, v4u (&kv)[8], bool has_next, int nb_, int nh_, int nkblk_, bool pre_, bool nown_, const int* nlist_, int nchunk0_, int qslot, int tflags = 0) {
    const bf16* Q1 = (const bf16*)F.out;
    bf16* PART = (bf16*)(F.ws + WS_PART); float* LSE = (float*)(F.ws + WS_LSE);
    LAS unsigned char* ring = F.lds + RING_OFF;
    const int tid = F.tid, lane = F.lane, wave = F.wave, r32 = lane & 31, hi = lane >> 5;
    const float slope2 = exp2f(-0.5f * (float)(h + 1)) * LOG2E;
    LAS float* wsf = (LAS float*)(ring + AT_WSF) + wave * 64;
    LAS bf16* stg = (LAS bf16*)(ring + AT_STG) + wave * 2048;
    int tq, slot; bool valid; bf16x8 qf[4];
    LAS const int* enl = (LAS const int*)(ring + AT_ENP) + wave * 64;
    auto load_q = [&](int chunk, int& tq_, int& slot_, bool& valid_, bf16x8 (&q_)[4], bool pre) {
        if (own) { tq_ = kblk * 256 + wave * 32 + r32; slot_ = 3; valid_ = true; }
        else { const int ei = chunk * 256 + wave * 32 + r32; valid_ = ei < cnt; unsigned l_ = (unsigned)lane; asm volatile("" : "+v"(l_)); const int en = valid_ ? (pre ? enl[l_] : list[ei]) : 0; tq_ = en >> 2; slot_ = en & 3; }
        const bf16x8* qp = (const bf16x8*)(Q1 + (size_t)(b * SEQ + tq_) * DM + h * HD + hi * 8);
#pragma unroll
        for (int ds = 0; ds < 4; ++ds) q_[ds] = qp[ds * 2];
    };
    if (pre_ && !own) asm volatile("s_waitcnt vmcnt(8)" ::: "memory");
    load_q(chunk0, tq, slot, valid, qf, pre_);
    LDS_WAIT();
    if (has_next && !nown_)
        __builtin_amdgcn_global_load_lds((const unsigned*)(nlist_ + nchunk0_ * 256 + wave * 32 + r32), (LAS unsigned*)(ring + AT_ENP + wave * 256), 4, 0, 0);
    if (has_next) {
        const char* gb; unsigned vo; unsigned t_ = (unsigned)tid; asm volatile("" : "+v"(t_));
        if (wave < 4) { gb = (const char*)F.out + 32 * MiB + ((size_t)(nb_ * SEQ + nkblk_ * 256) * DM + nh_ * HD) * 2; vo = t_ * (DM * 2); }
        else { gb = (const char*)(F.ws + WS_VT1) + ((size_t)(nh_ * HD) * M + nb_ * SEQ + nkblk_ * 256) * 2; vo = ((t_ - 256u) >> 2) * (M * 2) + ((t_ - 256u) & 3u) * 128u; }
        __builtin_amdgcn_global_load_lds((const unsigned*)(gb + vo), (LAS unsigned*)(ring + AT_DUMMY + wave * 256), 4, 0, 0);
    }
    if (tid == 0 && has_next) { const unsigned t_ = xb_add(F.ctl + CW_ATQ, 1u); *(volatile LAS unsigned*)(ring + AT_MBOX + 4 * qslot) = 2u * (unsigned)F.G + t_; }
    {
        const int r = tid >> 1, half = tid & 1;
        LAS v4u* dst = (LAS v4u*)(ring + AT_KS + r * AT_KSTRIDE + half * 64);
#pragma unroll
        for (int i = 0; i < 4; ++i) dst[i] = kv[i];
        const int d = tid >> 3, seg = tid & 7;
        LAS unsigned char* row = ring + AT_VS + d * AT_VSTRIDE;
#pragma unroll
        for (int i = 0; i < 4; ++i) { const v4u w = kv[4 + i]; const int g16 = seg * 2 + (i >> 1), hf = i & 1;
            *(LAS v2u*)(row + g16 * 32 + hf * 8) = (v2u){w.x, w.y}; *(LAS v2u*)(row + g16 * 32 + 16 + hf * 8) = (v2u){w.z, w.w}; }
    }
    __syncthreads();
    for (int ci = 0; ci < nchunk; ++ci) {
        int tqn = 0, slotn = 0; bool validn = false; bf16x8 qn[4];
        if (ci + 1 < nchunk) load_q(chunk0 + ci + 1, tqn, slotn, validn, qn, false);
        float m = -1e30f, l = 0.f;
        f32x16 o0, o1;
#pragma unroll
        for (int i = 0; i < 16; ++i) { o0[i] = 0.f; o1[i] = 0.f; }
        const int nkt = (tflags & 2) ? 0 : (own ? (wave >> 1) + 1 : 4);
        bf16x8 kf[8];
        if (nkt > 0) { const LAS unsigned char* kp = ring + AT_KS + ((nkt - 1) * 64 + r32) * AT_KSTRIDE + hi * 16;
#pragma unroll
            for (int ds = 0; ds < 4; ++ds) { kf[ds] = *(const LAS bf16x8*)(kp + ds * 32); kf[4 + ds] = *(const LAS bf16x8*)(kp + 32 * AT_KSTRIDE + ds * 32); } }
        for (int kt = nkt - 1; kt >= 0; --kt) {
            f32x16 p0, p1;
#pragma unroll
            for (int i = 0; i < 16; ++i) { p0[i] = 0.f; p1[i] = 0.f; }
            __builtin_amdgcn_s_setprio(1);
#pragma unroll
            for (int ds = 0; ds < 4; ++ds) { p0 = __builtin_amdgcn_mfma_f32_32x32x16_bf16(kf[ds], qf[ds], p0, 0, 0, 0); p1 = __builtin_amdgcn_mfma_f32_32x32x16_bf16(kf[4 + ds], qf[ds], p1, 0, 0, 0); }
            __builtin_amdgcn_s_setprio(0);
            if (kt > 0) { const LAS unsigned char* kp = ring + AT_KS + ((kt - 1) * 64 + r32) * AT_KSTRIDE + hi * 16;
#pragma unroll
                for (int ds = 0; ds < 4; ++ds) { kf[ds] = *(const LAS bf16x8*)(kp + ds * 32); kf[4 + ds] = *(const LAS bf16x8*)(kp + 32 * AT_KSTRIDE + ds * 32); } }
            bf16x8 vf[4];
            const LAS unsigned char* vp = ring + AT_VS + r32 * AT_VSTRIDE + kt * 128 + hi * 16;
#pragma unroll
            for (int sI = 0; sI < 2; ++sI) { vf[sI] = *(const LAS bf16x8*)(vp + sI * 32); vf[2 + sI] = *(const LAS bf16x8*)(vp + 32 * AT_VSTRIDE + sI * 32); }
            if (!(tflags & 4)) {
            const float c0 = slope2 * (float)(kblk * 256 + kt * 64 + 4 * hi - tq);
            float rm = -INFINITY;
            const bool diag = own && kt == nkt - 1;
            const int qrel = (wave & 1) * 32 + r32;
#pragma unroll
            for (int r = 0; r < 16; ++r) { const float bq = c0 + slope2 * (float)((r & 3) + 8 * (r >> 2)); p0[r] += bq; p1[r] += bq + 32.f * slope2; }
            if (diag) {
                int qr = qrel - 4 * hi; asm volatile("" : "+v"(qr) :: "memory");
#pragma unroll
                for (int r = 0; r < 16; ++r) { const int kr = (r & 3) + 8 * (r >> 2); if (kr > qr) p0[r] = -INFINITY; if (kr + 32 > qr) p1[r] = -INFINITY; }
            }
#pragma unroll
            for (int r = 0; r < 16; ++r) rm = __builtin_fmaxf(__builtin_fmaxf(rm, p0[r]), p1[r]);
            { auto rr = __builtin_amdgcn_permlane32_swap(__float_as_uint(rm), __float_as_uint(rm), false, false); rm = fmaxf(__uint_as_float(rr[0]), __uint_as_float(rr[1])); }
            const bool grow = rm > m + 8.f;
            const float mn = grow ? rm : m; const float f = __builtin_amdgcn_exp2f(m - mn); m = mn; l *= f;
            float ps = 0.f;
#pragma unroll
            for (int r = 0; r < 16; ++r) { p0[r] = __builtin_amdgcn_exp2f(p0[r] - mn); p1[r] = __builtin_amdgcn_exp2f(p1[r] - mn); ps += p0[r] + p1[r]; }
            l += ps;
            if (kt != nkt - 1 && __any(grow)) {
                if (hi == 0) wsf[r32] = f;
                LDS_WAIT();
#pragma unroll
                for (int i = 0; i < 16; ++i) { const float fi = wsf[crow16(i, hi)]; o0[i] *= fi; o1[i] *= fi; }
            }
            }
#pragma unroll
            for (int sI = 0; sI < 4; ++sI) { const f32x16& pp = (sI < 2) ? p0 : p1; const int q8 = (sI & 1) * 8;
                if (sI == 2) {
#pragma unroll
                    for (int s2 = 0; s2 < 2; ++s2) { vf[s2] = *(const LAS bf16x8*)(vp + (2 + s2) * 32); vf[2 + s2] = *(const LAS bf16x8*)(vp + 32 * AT_VSTRIDE + (2 + s2) * 32); } }
                v4u w; w.x = pg8::cvt_pk_bf16(pp[q8], pp[q8 + 1]); w.y = pg8::cvt_pk_bf16(pp[q8 + 2], pp[q8 + 3]); w.z = pg8::cvt_pk_bf16(pp[q8 + 4], pp[q8 + 5]); w.w = pg8::cvt_pk_bf16(pp[q8 + 6], pp[q8 + 7]);
                const bf16x8 pa = __builtin_bit_cast(bf16x8, w);
                o0 = __builtin_amdgcn_mfma_f32_32x32x16_bf16(pa, vf[sI & 1], o0, 0, 0, 0);
                o1 = __builtin_amdgcn_mfma_f32_32x32x16_bf16(pa, vf[2 + (sI & 1)], o1, 0, 0, 0); }
        }
        float lt; { auto rr = __builtin_amdgcn_permlane32_swap(__float_as_uint(l), __float_as_uint(l), false, false); lt = __uint_as_float(rr[0]) + __uint_as_float(rr[1]); }
        LDS_WAIT();
        if (hi == 0) wsf[r32] = 1.f / lt;
        LDS_WAIT();
#pragma unroll
        for (int i = 0; i < 16; ++i) { const int orow = crow16(i, hi); const float inv = wsf[orow];
            stg[orow * 64 + r32] = (bf16)f2bf(o0[i] * inv); stg[orow * 64 + 32 + r32] = (bf16)f2bf(o1[i] * inv); }
        LDS_WAIT();
        const int code = valid ? ((tq << 2) | slot) : -1;
#pragma unroll
        for (int i = 0; i < 4; ++i) { const int row = i * 8 + (lane >> 3), chn = lane & 7; const int cd = __shfl(code, row);
            const v4u v = *(const LAS v4u*)(stg + row * 64 + chn * 8);
            if (cd >= 0 && !(tflags & 1)) { const size_t prow = ((size_t)(b * SEQ + (cd >> 2)) * AH + h) * 4 + (cd & 3); *(v4u*)(PART + prow * HD + chn * 8) = v; } }
        if (hi == 0 && valid && !(tflags & 1)) LSE[((size_t)(b * SEQ + tq) * AH + h) * 4 + slot] = m + __builtin_amdgcn_logf(lt);
        LDS_WAIT();
        tq = tqn; slot = slotn; valid = validn;
#pragma unroll
        for (int ds = 0; ds < 4; ++ds) qf[ds] = qn[ds];
    }
    __syncthreads();
}

__device__ __forceinline__ void moba_attn_phase(Frame& F, int mode = 0, int tflags = 0) {
    const int* LCNT = (const int*)(F.ctl + CW_LCNT); const int* LISTS = (const int*)(F.ws + WS_LISTS);
    LAS int* pfx = (LAS int*)(F.lds + RING_OFF + AT_PFX);
    {
        const int c0 = (((LCNT[2 * F.tid] + 255) >> 8) + AT_SEG - 1) / AT_SEG, c1 = (((LCNT[2 * F.tid + 1] + 255) >> 8) + AT_SEG - 1) / AT_SEG;
        LAS int* tmp = pfx + 1032;
        tmp[F.tid] = c0 + c1; __syncthreads();
        for (int o = 1; o < NTHR; o <<= 1) { const int v = (F.tid >= o) ? tmp[F.tid - o] : 0; __syncthreads(); tmp[F.tid] += v; __syncthreads(); }
        const int incl = tmp[F.tid], excl = incl - (c0 + c1);
        pfx[2 * F.tid] = excl; pfx[2 * F.tid + 1] = excl + c0; if (F.tid == NTHR - 1) pfx[1024] = incl;
        __syncthreads();
    }
    const int nsegs = pfx[1024], total = 1024 + nsegs;
    const int ubeg = (mode == 1 ? nsegs + F.bx : F.bx), uend = (mode == 2 ? nsegs : total);
#define AT_DECODE(u_, ok_, b_, h_, kb_, own_, li_, cnt_, c0_, nc_) do { ok_ = (u_) < uend; b_ = 0; h_ = 0; kb_ = 0; own_ = false; li_ = 0; cnt_ = 0; c0_ = 0; nc_ = 1; \
        if (ok_) { if ((u_) < nsegs) { int lo = 0, hi_ = 1023; while (lo < hi_) { const int mid = (lo + hi_ + 1) >> 1; if (pfx[mid] <= (u_)) lo = mid; else hi_ = mid - 1; } \
                li_ = __builtin_amdgcn_readfirstlane(lo); const int seg_ = __builtin_amdgcn_readfirstlane((u_) - pfx[li_]); cnt_ = LCNT[li_]; const int nch_ = (cnt_ + 255) >> 8; c0_ = seg_ * AT_SEG; nc_ = (nch_ - c0_) < AT_SEG ? (nch_ - c0_) : AT_SEG; \
                b_ = li_ >> 9; h_ = (li_ >> 5) & 15; kb_ = li_ & 31; } \
            else { const int v_ = (u_) - nsegs; own_ = true; b_ = v_ >> 9; h_ = (v_ >> 5) & 15; kb_ = v_ & 31; } } } while (0)
    bool ok, own; int ub, uh, ukb, uli, ucnt, uc0, unc;
    int u = ubeg, un = ubeg + F.G, qs = 0;
    AT_DECODE(u, ok, ub, uh, ukb, own, uli, ucnt, uc0, unc);
    bool pre = false;
    while (ok) {
        v4u kv[8];
        attn_kv_load(F, ub, uh, ukb, kv);
        bool ok2, own2; int b2, h2, kb2, li2, cnt2, c02, nc2;
        AT_DECODE(un, ok2, b2, h2, kb2, own2, li2, cnt2, c02, nc2);
        attn_unit(F, ub, uh, ukb, own, LISTS + (size_t)uli * LIST_CAP, ucnt, uc0, unc, kv, ok2, b2, h2, kb2, pre, own2, LISTS + (size_t)li2 * LIST_CAP, c02, qs, tflags); pre = true;
        ok = ok2; own = own2; ub = b2; uh = h2; ukb = kb2; uli = li2; ucnt = cnt2; uc0 = c02; unc = nc2; u = un;
        if (ok2) un = __builtin_amdgcn_readfirstlane((int)*(volatile LAS unsigned*)(F.lds + RING_OFF + AT_MBOX + 4 * qs));
        qs ^= 1;
    }
#undef AT_DECODE
}

__device__ __forceinline__ void moba_combine_phase(Frame& F) {
    const bf16* PART = (const bf16*)(F.ws + WS_PART); const float* LSE = (const float*)(F.ws + WS_LSE); bf16* OB = (bf16*)(F.ws + WS_OB);
    const int gt = F.bx * NTHR + F.tid, NGT = F.G * NTHR;
    for (int e = gt; e < M * AH * 8; e += NGT) {
        const int chn = e & 7, th = e >> 3, hh = th & 15, m = th >> 4; const int j = (m % SEQ) >> 8; const int nsel = j < 3 ? j : 3;
        const float* ls = LSE + (size_t)th * 4;
        float lv[4]; lv[3] = ls[3]; float mx = lv[3];
#pragma unroll
        for (int k = 0; k < 3; ++k) { lv[k] = (k < nsel) ? ls[k] : -INFINITY; mx = fmaxf(mx, lv[k]); }
        v4u pp[4];
#pragma unroll
        for (int k = 0; k < 4; ++k) { pp[k] = (v4u){0u, 0u, 0u, 0u}; if ((k == 3 || k < nsel) && lv[k] > -INFINITY) pp[k] = __builtin_nontemporal_load((const v4u*)(PART + ((size_t)th * 4 + k) * HD + chn * 8)); }
        float acc[8], wsum = 0.f;
#pragma unroll
        for (int i = 0; i < 8; ++i) acc[i] = 0.f;
#pragma unroll
        for (int k = 0; k < 4; ++k) {
            const bool use = (k == 3 || k < nsel) && lv[k] > -INFINITY;
            const float w = use ? exp2f(lv[k] - mx) : 0.f; wsum += w;
            const v4u p = pp[k];
            if (use) { acc[0] += w * bflo(p.x); acc[1] += w * bfhi(p.x); acc[2] += w * bflo(p.y); acc[3] += w * bfhi(p.y); acc[4] += w * bflo(p.z); acc[5] += w * bfhi(p.z); acc[6] += w * bflo(p.w); acc[7] += w * bfhi(p.w); }
        }
        const float inv = 1.f / wsum;
        v4u o; o.x = pk2(acc[0] * inv, acc[1] * inv); o.y = pk2(acc[2] * inv, acc[3] * inv); o.z = pk2(acc[4] * inv, acc[5] * inv); o.w = pk2(acc[6] * inv, acc[7] * inv);
        *(v4u*)(OB + (size_t)m * DM + hh * HD + chn * 8) = o;
    }
}
__global__ void __launch_bounds__(NTHR, 2) mk_fwd(Args args) {
    extern __shared__ __attribute__((aligned(16))) unsigned char lds_raw[];
    Frame F;
    F.lds = (LAS unsigned char*)lds_raw;
    F.G = gridDim.x; F.bx = blockIdx.x; F.wave = __builtin_amdgcn_readfirstlane(threadIdx.x >> 6);
#define REFRESH() do { unsigned o_ = ~0u; asm volatile("" : "+s"(o_)); const int l_ = __builtin_amdgcn_mbcnt_hi(o_, __builtin_amdgcn_mbcnt_lo(o_, 0u)); F.lane = l_; asm volatile("" : "+s"(F.wave), "+s"(F.G), "+s"(F.bx)); F.tid = F.wave * 64 + l_; \
        kaptr_t k_ = (kaptr_t)__builtin_amdgcn_kernarg_segment_ptr(); asm volatile("" : "+s"(k_)); F.ka = k_; \
        F.out = *(float* const __attribute__((address_space(4)))*)(k_ + 200); F.ws = *(unsigned char* const __attribute__((address_space(4)))*)(k_ + 208); \
        F.ctl = (unsigned*)(F.ws + WS_CTL); F.ctlf = (float*)(F.ws + WS_CTL); F.smallf = (float*)(F.ws + WS_SMALL); } while (0)
    REFRESH();
    for (int u = F.tid; u < (LDS_BYTES - LDSCTL_OFF) / 4; u += NTHR) ((LAS unsigned*)(F.lds + LDSCTL_OFF))[u] = 0u;
    __syncthreads();
    if (F.tid == 0) F.ctl[CW_XCCTAB + F.bx] = xb_xcc_id();
    { XcdBarrier b0 = xcd_barrier_post(F.ctl + CW_BAR, (volatile LAS unsigned*)(F.lds + MISC_OFF) + 8); (void)b0; }
#define GRID_BAR() do { XcdBarrier b_; b_.bar = F.ctl + CW_BAR; b_.x = xb_xcc_id(); b_.st = (volatile LAS unsigned*)(F.lds + MISC_OFF) + 8; xcd_barrier(b_); REFRESH(); } while (0)
#define RING (F.lds + RING_OFF)
#define CONDP (F.ctlf + CW_COND)

    p0_phase(F);
    GRID_BAR();
    p1_phase(F);
    GRID_BAR();
    {
        SchedPlain S{(const char*)(F.ws + WS_H0), (const char*)(F.ws + WS_WIN), (char*)(F.ws + WS_XM), DM, DM, DI, M / 256, DI / 256, F.G, F.bx};
        EpiGen<SchedPlain> E{S};
        pg8::gemm_phase<EpiGen<SchedPlain>, SchedPlain, true, true>(RING, F.wave, DM, DM, DM, S, E);
    }
    GRID_BAR();
    p3_phase(F);
    GRID_BAR();
    p3b_phase(F);
    if (F.G >= 128) { const int p = (int)F.bx - 8, np = F.G - 8; p0_cond(F, COND_A, COND_B, p, np); __syncthreads(); p0_convert(F, 2048, 3584, p < 0 ? -1 : p - (COND_B - COND_A), np - (COND_B - COND_A)); }
    else { p0_cond(F, COND_A, COND_B, F.bx, F.G); __syncthreads(); p0_convert(F, 2048, 3584, F.bx, F.G); }
    __syncthreads();
    GRID_BAR();
#define MLSTM_CORE(bsel) do { \
        char* KB = (char*)F.out; char* KWT = (char*)F.out + 32 * MiB; \
        const char* Wq = (const char*)(F.ws + WS_WQKV); const char* Wk = Wq + (size_t)NH * DH * DH * 2; const char* Wv = Wk + (size_t)NH * DH * DH * 2; \
        { \
            SchedQK S{(const char*)(F.ws + WS_XC), Wq, Wk, (char*)(F.ws + WS_AQ), KB, bsel, F.G, F.bx}; \
            EpiQK E{S, KWT, F.smallf + SW_WK, F.ctlf + CW_DN}; \
            pg8::gemm_phase<EpiQK, SchedQK, true, true>(RING, F.wave, DI, DH, DH, S, E); \
        } \
        { \
            SchedKV S{(const char*)(F.ws + WS_XM), Wv, (char*)(F.ws + WS_BC), bsel, F.G, F.bx}; \
            EpiGen<SchedKV> E{S}; \
            pg8::gemm_phase<EpiGen<SchedKV>, SchedKV, true, true>(RING, F.wave, DH, DI, DH, S, E); \
        } \
        GRID_BAR(); \
        { \
            SchedS S{(char*)(F.ws + WS_AQ), KB, F.smallf + SW_CS, F.ctlf + CW_DENI, bsel, F.G, F.bx}; \
            EpiGen<SchedS> E{S}; \
            pg8::gemm_phase<EpiGen<SchedS>, SchedS, false, true>(RING, F.wave, 768, DI, DH, S, E); \
        } \
        { \
            SchedDC S{(char*)(F.ws + WS_BC), KWT, F.G, F.bx}; \
            EpiGen<SchedDC> E{S}; \
            pg8::gemm_phase<EpiGen<SchedDC>, SchedDC, true, true>(RING, F.wave, 768, 256, 256, S, E); \
        } \
        GRID_BAR(); \
        p6_phase(F, bsel); \
        GRID_BAR(); \
        { \
            SchedH S{(const char*)(F.ws + WS_AQ), (const char*)(F.ws + WS_BC), (char*)(F.ws + WS_XM), F.smallf + SW_DENF, (float*)(F.ws + WS_HSTAT), bsel, F.G, F.bx}; \
            EpiGen<SchedH> E{S}; \
            pg8::gemm_phase<EpiGen<SchedH>, SchedH, false, true>(RING, F.wave, 768, 768, 768, S, E); \
        } \
        GRID_BAR(); \
    } while (0)
    MLSTM_CORE(0);
    MLSTM_CORE(1);
#undef MLSTM_CORE
    const bool p8split = F.G >= 16 && (F.G & 15) == 0; const int p8p = (int)((F.bx >> 4) * 8 + (F.bx & 7)); constexpr int P8_CUT = NE * 768 * 5 / 8;
    if (p8split) moe_weights_part(F, 0, WS_MOEW0, ((F.bx >> 3) & 1) ? p8p : -1, F.G / 2, 0, P8_CUT);
    else moe_weights_phase(F, 0, WS_MOEW0);
    __syncthreads();
    {
        SchedPlain S{(const char*)(F.ws + WS_H0), (const char*)(F.ws + WS_WIN) + (size_t)DI * DM * 2, (char*)(F.ws + WS_HHB), DM, DM, DI, M / 256, DI / 256, F.G, F.bx};
        EpiZ E{S, (const bf16*)(F.ws + WS_XM), (const bf16*)(F.ws + WS_XC), (float*)(F.ws + WS_HSTAT), KIN(F, I_AGN), KIN(F, I_ASKIP)};
        pg8::gemm_phase<EpiZ, SchedPlain, true, true>(RING, F.wave, DM, DM, DM, S, E);
    }
    if (p8split) { __syncthreads(); moe_weights_part(F, 0, WS_MOEW0, ((F.bx >> 3) & 1) ? -1 : p8p, F.G / 2, P8_CUT, NE * 768); __syncthreads(); }
    GRID_BAR();
    {
        SchedPlain S{(const char*)(F.ws + WS_HHB), (const char*)(F.ws + WS_WOUT), (char*)(F.ws + WS_U0), DI, DI, DM, M / 256, DM / 256, F.G, F.bx};
        EpiGen<SchedPlain> E{S};
        pg8::gemm_phase<EpiGen<SchedPlain>, SchedPlain, false, true>(RING, F.wave, DI, DI, DI, S, E);
    }
    GRID_BAR();
    moe_route_phase<true>(F, KIN(F, I_X), nullptr, 0, (const bf16*)(F.ws + WS_U0), (bf16*)(F.ws + WS_HMOE0), 0, 0, 0);
    GRID_BAR();
    {
        const int nb = moe_build_table(F, 0);
        SchedMoe S{(const char*)(F.ws + WS_HMOE0), (const char*)(F.ws + WS_MOEW0), (char*)F.out, (LAS const int*)(F.lds + LDS_TAB_OFF), (const int*)(F.smallf + SW_BT), 1, DM, DM, DFF, 128, 1024}; S.map(nb, F.G, F.bx, 0);
        EpiMoe1 E{S, nullptr, nullptr, false};
        pg8::gemm_phase<EpiMoe1, SchedMoe, true, true, true>(RING, F.wave, DM, DM, DM, S, E, (LAS int*)(F.lds + LDS_TAB_OFF + 2048));
        int maxc = 0, np = 0, p = -1;
        for (int x = 0; x < 8; ++x) { SchedMoe T = S; T.map(nb, F.G, x, 0); const int c0 = (T.nbx4 + T.Gx - 1) / T.Gx; maxc = c0 > maxc ? c0 : maxc; }
        for (int x = 0; x < 8; ++x) { SchedMoe T = S; T.map(nb, F.G, x, 0); int hv = T.nbx4 - (maxc - 1) * T.Gx; hv = hv < 0 ? 0 : (hv > T.Gx ? T.Gx : hv);
            if (x == S.x && S.j >= hv) p = np + (S.j - hv); np += T.Gx - hv; }
        __syncthreads();
        if (np >= 64) moe_weights_part(F, 1, WS_MOEW1, p, np); else moe_weights_part(F, 1, WS_MOEW1, F.bx, F.G);
    }
    GRID_BAR();
    {
        const int nb = moe_build_table(F, 0);
        SchedMoe S{(const char*)F.out, (const char*)(F.ws + WS_MOEW0) + (size_t)NE * 1024 * 1024 * 2, (char*)(F.ws + WS_YS0), (LAS const int*)(F.lds + LDS_TAB_OFF), nullptr, 0, DFF, DFF, DM, 256, 1024}; S.map(nb, F.G, F.bx, 0);
        EpiGen<SchedMoe> E{S};
        pg8::gemm_phase<EpiGen<SchedMoe>, SchedMoe, true, true>(RING, F.wave, DFF, DFF, DFF, S, E);
        int maxc = 0, np = 0, p = -1;
        for (int x = 0; x < 8; ++x) { SchedMoe T = S; T.map(nb, F.G, x, 0); const int c0 = (T.nbx4 + T.Gx - 1) / T.Gx; maxc = c0 > maxc ? c0 : maxc; }
        for (int x = 0; x < 8; ++x) { SchedMoe T = S; T.map(nb, F.G, x, 0); int hv = T.nbx4 - (maxc - 1) * T.Gx; hv = hv < 0 ? 0 : (hv > T.Gx ? T.Gx : hv);
            if (x == S.x && S.j >= hv) p = np + (S.j - hv); np += T.Gx - hv; }
        __syncthreads();
        if (np >= 200) { p0_cond(F, COND_B, 256, p, np); __syncthreads(); p0_convert(F, 4608, 6656, p < 0 ? -1 : p - (256 - COND_B), np - (256 - COND_B)); }
        else { p0_cond(F, COND_B, 256, F.bx, F.G); __syncthreads(); p0_convert(F, 4608, 6656, F.bx, F.G); }
        __syncthreads();
    }
    GRID_BAR();
    moe_combine_phase(F, (const bf16*)(F.ws + WS_HMOE0), (const bf16*)(F.ws + WS_YS0), nullptr, 0, 1, (bf16*)(F.ws + WS_H1), (bf16*)(F.ws + WS_HKV));
    GRID_BAR();
    {
        SchedQKV1 S{(const char*)(F.ws + WS_H1), (const char*)(F.ws + WS_HKV), (const char*)(F.ws + WS_WQ1), (const char*)(F.ws + WS_WKV), (char*)F.out, (char*)F.out + 32 * MiB, (char*)(F.ws + WS_VT1), F.ctlf + CW_KM, F.G, F.bx};
        EpiQKV1 E{S, F.ctlf + CW_KNP};
        pg8::gemm_phase<EpiQKV1, SchedQKV1, true, true>(RING, F.wave, DM, DM, DM, S, E);
    }
    GRID_BAR();
    moba_route_phase(F, 0);
    GRID_BAR();
    moba_attn_phase(F);
    GRID_BAR();
    moba_combine_phase(F);
    GRID_BAR();
    {
        SchedPlain S{(const char*)(F.ws + WS_OB), (const char*)(F.ws + WS_WO1), (char*)F.out, DM, DM, DM, M / 256, DM / 256, F.G, F.bx};
        EpiGen<SchedPlain> E{S};
        pg8::gemm_phase<EpiGen<SchedPlain>, SchedPlain, false, true>(RING, F.wave, DM, DM, DM, S, E);
    }
    GRID_BAR();
    moe_route_phase<false>(F, nullptr, (const bf16*)(F.ws + WS_H1), mod_off(1, 0, 0), (const bf16*)F.out, (bf16*)(F.ws + WS_HMOE1), 1, 2, 1);
    GRID_BAR();
    {
        const int nb = moe_build_table(F, 1);
        SchedMoe S{(const char*)(F.ws + WS_HMOE1), (const char*)(F.ws + WS_MOEW1), (char*)(F.ws + WS_ACT1), (LAS const int*)(F.lds + LDS_TAB_OFF), (const int*)(F.smallf + SW_BT), 1, DM, DM, DFF, 128, 1024}; S.map(nb, F.G, F.bx, 0);
        EpiMoe1 E{S, F.ctl + CW_SIG, (LAS unsigned*)(F.lds + MISC_OFF) + 16, moe_group_same_xcd(F, S.x, S.Gx)};
        pg8::gemm_phase<EpiMoe1, SchedMoe, true, true, true>(RING, F.wave, DM, DM, DM, S, E, (LAS int*)(F.lds + LDS_TAB_OFF + 2048));
    }
    {
        const int nb = moe_build_table(F, 1);
        SchedMoe S{(const char*)(F.ws + WS_ACT1), (const char*)(F.ws + WS_MOEW1) + (size_t)NE * 1024 * 1024 * 2, (char*)(F.ws + WS_YS1), (LAS const int*)(F.lds + LDS_TAB_OFF), nullptr, 0, DFF, DFF, DM, 256, 1024}; S.map(nb, F.G, F.bx, 1);
        moe_wait_first(F, S, moe_group_same_xcd(F, S.x, S.Gx));
        EpiGen<SchedMoe> E{S};
        pg8::gemm_phase<EpiGen<SchedMoe>, SchedMoe, true, true>(RING, F.wave, DFF, DFF, DFF, S, E);
    }
    GRID_BAR();
    moe_combine_phase(F, (const bf16*)(F.ws + WS_HMOE1), (const bf16*)(F.ws + WS_YS1), F.out, 1, 3, nullptr, nullptr);
}

extern "C" void kernel_launch(void* const* d_in, const int* in_sizes, int n_in, void* d_out, int out_size, void* d_ws, size_t ws_size, hipStream_t stream) {
    static int grid = 0;
    if (grid == 0) {
        if (n_in != 25 || out_size != M * DM || ws_size < WS_END) { fprintf(stderr, "kernel_launch: unexpected shapes (n_in %d out %d ws %zu)\n", n_in, out_size, ws_size); grid = -1; return; }
        int dev = 0, cus = 0, per_cu = 0;
        if (hipGetDevice(&dev) != hipSuccess || hipDeviceGetAttribute(&cus, hipDeviceAttributeMultiprocessorCount, dev) != hipSuccess) { grid = -1; return; }
        if (hipFuncSetAttribute((const void*)mk_fwd, hipFuncAttributeMaxDynamicSharedMemorySize, LDS_BYTES) != hipSuccess) { fprintf(stderr, "kernel_launch: hipFuncSetAttribute failed\n"); grid = -1; return; }
        if (hipOccupancyMaxActiveBlocksPerMultiprocessor(&per_cu, (const void*)mk_fwd, NTHR, LDS_BYTES) != hipSuccess || per_cu < 1) { fprintf(stderr, "kernel_launch: occupancy query says %d blocks/CU\n", per_cu); (void)hipGetLastError(); grid = -1; return; }
        grid = cus;
    }
    if (grid < 0) return;
    (void)hipMemsetAsync((char*)d_ws + WS_CTL, 0, CTL_ZERO_BYTES, stream);
    Args a{};
    for (int i = 0; i < 25; ++i) a.in[i] = (const float*)d_in[i];
    a.out = (float*)d_out; a.ws = (unsigned char*)d_ws; a.ph_lo = 0; a.ph_hi = 0;
    hipLaunchKernelGGL(mk_fwd, dim3(grid), dim3(NTHR), LDS_BYTES, stream, a);
}
```
